# Optimizing an MI355X kernel written in HIP

```python
import jax, jax.numpy as jnp
from jax import lax
import numpy as np

D_MODEL = 1024
BATCH = 16
SEQ = 256
DEPTH = 4
DEC_BATCH = 4
DEC_SEQ = 2048
PAST_LEN = 512

GRID_W = 64
HEAD_DIM = 64
NA_HEADS = 4
NA_WIN_ROWS = 8
NA_WIN_COLS = 16
NA_QCOLS = 16
NA_KCOLS = 32
POOL_GROUPS = 4
POOL_GW = 64
POOL_WINDOWS = (2, 4, 8, 16)
MLA_HEADS = 4
MLA_Q_RANK = 256
MLA_KV_RANK = 128
MLA_NOPE = 64
MLA_ROPE = 32
MLA_V = 64
SWA_HEADS = 4
SWA_KV_HEADS = 2
SWA_WINDOW = 128
SWA_BLOCK = 128
D_FF = 4 * D_MODEL
Q_BLOCK = 128
ROPE_THETA = 10000.0
EPS = 1e-6
NEG = -1e30
IN_SIZES = (NA_HEADS * HEAD_DIM, NA_HEADS * HEAD_DIM, NA_HEADS * HEAD_DIM,
            POOL_GROUPS * POOL_GW,
            MLA_Q_RANK, MLA_KV_RANK, MLA_ROPE,
            SWA_HEADS * HEAD_DIM, SWA_KV_HEADS * HEAD_DIM, SWA_KV_HEADS * HEAD_DIM)
IN_COLS = sum(IN_SIZES)
MIX_WIDTH = NA_HEADS * HEAD_DIM + POOL_GROUPS * POOL_GW + MLA_HEADS * MLA_V + SWA_HEADS * HEAD_DIM

kernel_name = 'hybrid_dit_parallel_heads_step'


def rms_norm(x, g):
    xf = x.astype(jnp.float32)
    xf = xf * lax.rsqrt(jnp.mean(xf * xf, axis=-1, keepdims=True) + EPS)
    return (xf * g.astype(jnp.float32)).astype(x.dtype)


def adaln(cond, w, b):
    return jnp.split(jax.nn.silu(cond) @ w + b, 6, axis=-1)


def axial_rope(x, rows, cols):
    half = x.shape[-1] // 2
    quarter = half // 2
    freqs = ROPE_THETA ** (-jnp.arange(quarter, dtype=jnp.float32) / quarter)

    def rotate(xa, pos):
        ang = pos.astype(jnp.float32)[:, None] * freqs
        cos = jnp.cos(ang)[:, None, :]
        sin = jnp.sin(ang)[:, None, :]
        x1, x2 = xa[..., :quarter], xa[..., quarter:]
        return jnp.concatenate([x1 * cos - x2 * sin, x1 * sin + x2 * cos], axis=-1)

    xf = x.astype(jnp.float32)
    out = jnp.concatenate([rotate(xf[..., :half], rows), rotate(xf[..., half:], cols)], axis=-1)
    return out.astype(x.dtype)


def rope_tail(x, start, rows, cols):
    return jnp.concatenate([x[..., :start], axial_rope(x[..., start:], rows, cols)], axis=-1)


def dense_attention(q, k, v, sink=None):
    b, nq, h, dk = q.shape
    scale = dk ** -0.5
    qb = q.reshape(b, nq // Q_BLOCK, Q_BLOCK, h, dk).swapaxes(0, 1)

    def block(qi):
        s = jnp.einsum('bqhd,bkhd->bhqk', qi, k).astype(jnp.float32) * scale
        if sink is not None:
            s_sink = jnp.broadcast_to(sink.astype(jnp.float32)[None, :, None, None], s.shape[:-1] + (1,))
            p = jax.nn.softmax(jnp.concatenate([s, s_sink], axis=-1), axis=-1)[..., :-1]
        else:
            p = jax.nn.softmax(s, axis=-1)
        return jnp.einsum('bhqk,bkhd->bqhd', p.astype(v.dtype), v)

    out = lax.map(block, qb)
    return out.swapaxes(0, 1).reshape(b, nq, h, v.shape[-1])


def neighbourhood_attention(q, k, v, ctx_k, ctx_v, rpb):
    b, n, h, d = q.shape
    rows = n // GRID_W
    wr = min(NA_WIN_ROWS, rows)
    ncb = GRID_W // NA_QCOLS
    qr = jnp.arange(rows)
    key_rows = jnp.clip(qr - wr // 2, 0, rows - wr)[:, None] + jnp.arange(wr)[None, :]
    qcol = jnp.arange(GRID_W).reshape(ncb, NA_QCOLS)
    col_start = jnp.clip(qcol - NA_WIN_COLS // 2, 0, GRID_W - NA_WIN_COLS)
    key_cols = jnp.clip(col_start[:, :1], 0, GRID_W - NA_KCOLS) + jnp.arange(NA_KCOLS)[None, :]
    nk = wr * NA_KCOLS

    def gather(x):
        xg = x.reshape(b, rows, GRID_W, h, d)
        blk = xg[:, key_rows[:, None, :, None], key_cols[None, :, None, :]]
        return blk.reshape(b, rows, ncb, nk, h, d)

    kb, vb = gather(k), gather(v)
    qg = q.reshape(b, rows, ncb, NA_QCOLS, h, d)
    inside = (key_cols[:, None, :] >= col_start[:, :, None]) & (key_cols[:, None, :] < col_start[:, :, None] + NA_WIN_COLS)
    mask = jnp.broadcast_to(inside[:, :, None, :], (ncb, NA_QCOLS, wr, NA_KCOLS)).reshape(ncb, NA_QCOLS, nk)
    dr = key_rows - qr[:, None] + NA_WIN_ROWS - 1
    dc = jnp.clip(key_cols[:, None, :] - qcol[:, :, None] + NA_WIN_COLS - 1, 0, 2 * NA_WIN_COLS - 2)
    bias = rpb[:, dr[:, None, None, :, None], dc[None, :, :, None, :]]
    bias = bias.transpose(1, 2, 0, 3, 4, 5).reshape(rows, ncb, h, NA_QCOLS, nk).astype(jnp.float32)
    scale = d ** -0.5
    s_loc = jnp.einsum('brcqhd,brckhd->brchqk', qg, kb).astype(jnp.float32) * scale + bias
    s_loc = jnp.where(mask[None, None, :, None, :, :], s_loc, NEG)
    s_ctx = jnp.einsum('brcqhd,blhd->brchql', qg, ctx_k).astype(jnp.float32) * scale
    p = jax.nn.softmax(jnp.concatenate([s_loc, s_ctx], axis=-1), axis=-1).astype(v.dtype)
    out = (jnp.einsum('brchqk,brckhd->brcqhd', p[..., :nk], vb)
           + jnp.einsum('brchql,blhd->brcqhd', p[..., nk:], ctx_v))
    return out.reshape(b, n, h, d)


def window_attention(q, k, v, ctx_k, ctx_v, sink):
    b, n, hq, d = q.shape
    nb = n // SWA_BLOCK
    g = hq // SWA_KV_HEADS
    qb = q.reshape(b, nb, SWA_BLOCK, SWA_KV_HEADS, g, d)

    def band(x):
        xp = jnp.pad(x, ((0, 0), (SWA_BLOCK, SWA_BLOCK), (0, 0), (0, 0)))
        xp = xp.reshape(b, nb + 2, SWA_BLOCK, SWA_KV_HEADS, d)
        return jnp.concatenate([xp[:, :nb], xp[:, 1:nb + 1], xp[:, 2:]], axis=2)

    kb, vb = band(k), band(v)
    kl = 3 * SWA_BLOCK
    qpos = jnp.arange(n).reshape(nb, SWA_BLOCK)
    kpos = (jnp.arange(nb)[:, None] - 1) * SWA_BLOCK + jnp.arange(kl)[None, :]
    valid = ((kpos[:, None, :] >= 0) & (kpos[:, None, :] < n)
             & (jnp.abs(kpos[:, None, :] - qpos[:, :, None]) <= SWA_WINDOW))
    scale = d ** -0.5
    s_loc = jnp.einsum('bnqhgd,bnjhd->bnhgqj', qb, kb).astype(jnp.float32) * scale
    s_loc = jnp.where(valid[None, :, None, None, :, :], s_loc, NEG)
    s_ctx = jnp.einsum('bnqhgd,blhd->bnhgql', qb, ctx_k).astype(jnp.float32) * scale
    s_sink = jnp.broadcast_to(sink.astype(jnp.float32).reshape(SWA_KV_HEADS, g)[None, None, :, :, None, None],
                              s_loc.shape[:-1] + (1,))
    p = jax.nn.softmax(jnp.concatenate([s_loc, s_ctx, s_sink], axis=-1), axis=-1).astype(v.dtype)
    out = (jnp.einsum('bnhgqj,bnjhd->bnqhgd', p[..., :kl], vb)
           + jnp.einsum('bnhgql,blhd->bnqhgd', p[..., kl:-1], ctx_v))
    return out.reshape(b, n, hq, d)


def multiscale_pool(x, w_pool, scale):
    b, n, _ = x.shape
    xf = x.astype(jnp.float32)
    t = jnp.arange(n)
    outs = []
    for gi, w in enumerate(POOL_WINDOWS):
        xg = xf[..., gi * POOL_GW:(gi + 1) * POOL_GW]
        cs = jnp.pad(jnp.cumsum(xg, axis=1), ((0, 0), (1, 0), (0, 0)))
        lo = jnp.clip(t - w // 2, 0, n)
        hi = jnp.clip(t - w // 2 + w, 0, n)
        mean = (cs[:, hi] - cs[:, lo]) / (hi - lo).astype(jnp.float32)[None, :, None]
        outs.append(mean - xg)
    pooled = jnp.stack(outs, axis=2).astype(x.dtype)
    y = jnp.einsum('bngc,gce->bnge', pooled, w_pool).reshape(b, n, POOL_GROUPS * POOL_GW)
    return y * scale


def project_mixers(h, p):
    b, n, _ = h.shape
    offs = np.cumsum(IN_SIZES)[:-1].tolist()
    (na_q, na_k, na_v, pool_in, mla_cq, mla_ckv, mla_kpe,
     swa_q, swa_k, swa_v) = jnp.split(h @ p['w_in'], offs, axis=-1)
    heads = lambda z, nh: z.reshape(b, n, nh, -1)
    na = (rms_norm(heads(na_q, NA_HEADS), p['na_q_norm']),
          rms_norm(heads(na_k, NA_HEADS), p['na_k_norm']),
          heads(na_v, NA_HEADS))
    mla_q = rms_norm(heads(rms_norm(mla_cq, p['mla_q_a_norm']) @ p['mla_w_uq'], MLA_HEADS), p['mla_q_norm'])
    ckv = rms_norm(mla_ckv, p['mla_kv_norm'])
    swa = (rms_norm(heads(swa_q, SWA_HEADS), p['swa_q_norm']),
           rms_norm(heads(swa_k, SWA_KV_HEADS), p['swa_k_norm']),
           heads(swa_v, SWA_KV_HEADS))
    return na, pool_in, mla_q, ckv, mla_kpe, swa


def mla_expand_kv(ckv, kpe, p):
    b, n, _ = ckv.shape
    kv = (ckv @ p['mla_w_ukv']).reshape(b, n, MLA_HEADS, MLA_NOPE + MLA_V)
    k_pe = jnp.broadcast_to(kpe[:, :, None, :], (b, n, MLA_HEADS, MLA_ROPE))
    k = rms_norm(jnp.concatenate([kv[..., :MLA_NOPE], k_pe], axis=-1), p['mla_k_norm'])
    return k, kv[..., MLA_NOPE:]


def channel_mlp(x, shift, scale, gate, p):
    h = rms_norm(x, p['norm2']) * (1 + scale) + shift
    z = jax.nn.relu(h @ p['mlp_w1'])
    return x + gate * ((z * z) @ p['mlp_w2'])


def context_layer(x, mod, p):
    sh1, sc1, g1, sh2, sc2, g2 = mod
    h = rms_norm(x, p['norm1']) * (1 + sc1) + sh1
    b, n, _ = h.shape
    (na_q, na_k, na_v), pool_in, mla_q, ckv, kpe, (sq, sk, sv) = project_mixers(h, p)
    o_na = dense_attention(na_q, na_k, na_v)
    o_pool = multiscale_pool(pool_in, p['pool_w'], p['pool_scale'])
    mk, mv = mla_expand_kv(ckv, kpe, p)
    o_mla = dense_attention(mla_q, mk, mv)
    rep = SWA_HEADS // SWA_KV_HEADS
    o_swa = dense_attention(sq, jnp.repeat(sk, rep, axis=2), jnp.repeat(sv, rep, axis=2), sink=p['swa_sink'])
    mixed = jnp.concatenate([o_na.reshape(b, n, -1), o_pool, o_mla.reshape(b, n, -1), o_swa.reshape(b, n, -1)], axis=-1)
    x = x + g1 * (mixed @ p['w_out'])
    return channel_mlp(x, sh2, sc2, g2, p), (na_k, na_v, ckv, kpe, sk, sv)


def latent_layer(x, mod, cache, rows, cols, p):
    sh1, sc1, g1, sh2, sc2, g2 = mod
    c_na_k, c_na_v, c_ckv, c_kpe, c_swa_k, c_swa_v = cache
    h = rms_norm(x, p['norm1']) * (1 + sc1) + sh1
    b, n, _ = h.shape
    (na_q, na_k, na_v), pool_in, mla_q, ckv, kpe, (sq, sk, sv) = project_mixers(h, p)
    o_na = neighbourhood_attention(na_q, na_k, na_v, c_na_k, c_na_v, p['na_rpb'])
    o_pool = multiscale_pool(pool_in, p['pool_w'], p['pool_scale'])
    mk, mv = mla_expand_kv(ckv, kpe, p)
    ck, cv = mla_expand_kv(c_ckv, c_kpe, p)
    q = rope_tail(mla_q, MLA_NOPE, rows, cols)
    mk = rope_tail(mk, MLA_NOPE, rows, cols)
    o_mla = dense_attention(q, jnp.concatenate([mk, ck], axis=1), jnp.concatenate([mv, cv], axis=1))
    o_swa = window_attention(axial_rope(sq, rows, cols), axial_rope(sk, rows, cols), sv, c_swa_k, c_swa_v, p['swa_sink'])
    mixed = jnp.concatenate([o_na.reshape(b, n, -1), o_pool, o_mla.reshape(b, n, -1), o_swa.reshape(b, n, -1)], axis=-1)
    x = x + g1 * (mixed @ p['w_out'])
    return channel_mlp(x, sh2, sc2, g2, p)


def setup_inputs(seed: int = 0) -> dict:
    key = jax.random.key(seed)
    keys = jax.random.split(key, 40)
    ki = iter(range(40))

    def normal(shape, scale):
        return jax.random.normal(keys[next(ki)], shape, jnp.float32) * scale

    def gain(shape):
        return 1.0 + normal(shape, 0.05)

    d = D_MODEL
    return {
        'x_prompt': normal((BATCH, SEQ, d), 1.0),
        'x_sample': normal((DEC_BATCH, DEC_SEQ, d), 1.0),
        'cache_na_k': normal((DEC_BATCH, DEPTH, PAST_LEN, NA_HEADS, HEAD_DIM), 1.0),
        'cache_na_v': normal((DEC_BATCH, DEPTH, PAST_LEN, NA_HEADS, HEAD_DIM), 1.0),
        'cache_mla_ckv': normal((DEC_BATCH, DEPTH, PAST_LEN, MLA_KV_RANK), 1.0),
        'cache_mla_kpe': normal((DEC_BATCH, DEPTH, PAST_LEN, MLA_ROPE), 1.0),
        'cache_swa_k': normal((DEC_BATCH, DEPTH, PAST_LEN, SWA_KV_HEADS, HEAD_DIM), 1.0),
        'cache_swa_v': normal((DEC_BATCH, DEPTH, PAST_LEN, SWA_KV_HEADS, HEAD_DIM), 1.0),
        'c': normal((DEC_BATCH, d), 1.0),
        'c_ctx': normal((d,), 1.0),
        'norm1': gain((DEPTH, d)),
        'norm2': gain((DEPTH, d)),
        'w_ada': normal((DEPTH, d, 6 * d), 0.5 * d ** -0.5),
        'b_ada': normal((DEPTH, 6 * d), 0.02),
        'w_in': normal((DEPTH, d, IN_COLS), d ** -0.5),
        'w_out': normal((DEPTH, MIX_WIDTH, d), MIX_WIDTH ** -0.5),
        'na_q_norm': gain((DEPTH, HEAD_DIM)),
        'na_k_norm': gain((DEPTH, HEAD_DIM)),
        'na_rpb': normal((DEPTH, NA_HEADS, 2 * NA_WIN_ROWS - 1, 2 * NA_WIN_COLS - 1), 0.5),
        'pool_w': normal((DEPTH, POOL_GROUPS, POOL_GW, POOL_GW), POOL_GW ** -0.5),
        'pool_scale': gain((DEPTH, POOL_GROUPS * POOL_GW)),
        'mla_q_a_norm': gain((DEPTH, MLA_Q_RANK)),
        'mla_w_uq': normal((DEPTH, MLA_Q_RANK, MLA_HEADS * (MLA_NOPE + MLA_ROPE)), MLA_Q_RANK ** -0.5),
        'mla_kv_norm': gain((DEPTH, MLA_KV_RANK)),
        'mla_w_ukv': normal((DEPTH, MLA_KV_RANK, MLA_HEADS * (MLA_NOPE + MLA_V)), MLA_KV_RANK ** -0.5),
        'mla_q_norm': gain((DEPTH, MLA_NOPE + MLA_ROPE)),
        'mla_k_norm': gain((DEPTH, MLA_NOPE + MLA_ROPE)),
        'swa_q_norm': gain((DEPTH, HEAD_DIM)),
        'swa_k_norm': gain((DEPTH, HEAD_DIM)),
        'swa_sink': normal((DEPTH, SWA_HEADS), 1.0),
        'mlp_w1': normal((DEPTH, d, D_FF), d ** -0.5),
        'mlp_w2': normal((DEPTH, D_FF, d), D_FF ** -0.5),
    }


def reference(x_prompt, x_sample, cache_na_k, cache_na_v, cache_mla_ckv, cache_mla_kpe, cache_swa_k, cache_swa_v,
              c, c_ctx, norm1, norm2, w_ada, b_ada, w_in, w_out, na_q_norm, na_k_norm, na_rpb, pool_w, pool_scale,
              mla_q_a_norm, mla_w_uq, mla_kv_norm, mla_w_ukv, mla_q_norm, mla_k_norm, swa_q_norm, swa_k_norm,
              swa_sink, mlp_w1, mlp_w2):
    n_lat = x_sample.shape[1]
    t = jnp.arange(n_lat, dtype=jnp.int32)
    rows, cols = t // GRID_W, t % GRID_W
    xp, xs = x_prompt, x_sample
    st_na_k, st_na_v, st_ckv, st_kpe, st_swa_k, st_swa_v = [], [], [], [], [], []
    for l in range(DEPTH):
        p = {
            'norm1': norm1[l], 'norm2': norm2[l], 'w_in': w_in[l], 'w_out': w_out[l],
            'na_q_norm': na_q_norm[l], 'na_k_norm': na_k_norm[l], 'na_rpb': na_rpb[l],
            'pool_w': pool_w[l], 'pool_scale': pool_scale[l],
            'mla_q_a_norm': mla_q_a_norm[l], 'mla_w_uq': mla_w_uq[l], 'mla_kv_norm': mla_kv_norm[l],
            'mla_w_ukv': mla_w_ukv[l], 'mla_q_norm': mla_q_norm[l], 'mla_k_norm': mla_k_norm[l],
            'swa_q_norm': swa_q_norm[l], 'swa_k_norm': swa_k_norm[l], 'swa_sink': swa_sink[l],
            'mlp_w1': mlp_w1[l], 'mlp_w2': mlp_w2[l],
        }
        mod_ctx = adaln(c_ctx, w_ada[l], b_ada[l])
        xp, (k_na, v_na, ckv, kpe, k_swa, v_swa) = context_layer(xp, mod_ctx, p)
        st_na_k.append(k_na)
        st_na_v.append(v_na)
        st_ckv.append(ckv)
        st_kpe.append(kpe)
        st_swa_k.append(k_swa)
        st_swa_v.append(v_swa)
        mod_lat = adaln(c[:, None, :], w_ada[l], b_ada[l])
        cache_l = (cache_na_k[:, l], cache_na_v[:, l], cache_mla_ckv[:, l], cache_mla_kpe[:, l],
                   cache_swa_k[:, l], cache_swa_v[:, l])
        xs = latent_layer(xs, mod_lat, cache_l, rows, cols, p)
    na_k_new = jnp.stack(st_na_k, axis=1)
    na_v_new = jnp.stack(st_na_v, axis=1)
    mla_ckv_new = jnp.stack(st_ckv, axis=1)
    mla_kpe_new = jnp.stack(st_kpe, axis=1)
    swa_k_new = jnp.stack(st_swa_k, axis=1)
    swa_v_new = jnp.stack(st_swa_v, axis=1)
    return (xp, xs, na_k_new, na_v_new, mla_ckv_new, mla_kpe_new, swa_k_new, swa_v_new)
```

```cpp
#include <hip/hip_runtime.h>
#include <hip/hip_cooperative_groups.h>
#include <cstdio>
#include <cstdint>
namespace cg = cooperative_groups;
#ifndef MK_XCD_BARRIER
#define MK_XCD_BARRIER 0
#endif
namespace pg8 {
#define PG8_LAS __attribute__((address_space(3)))
typedef unsigned short bf16_t;
typedef short bf16x8 __attribute__((ext_vector_type(8)));
typedef float f32x4 __attribute__((ext_vector_type(4)));
typedef unsigned u32x4 __attribute__((ext_vector_type(4)));
constexpr int BM = 256, BK = 64, HALF = 128, HTB = HALF * BK * 2  , STAGE_BYTES = 8 * HTB, NXCD = 8, WGM = 8;

__host__ __device__ __forceinline__ int lds_byte(int r, int c) { const int st = (r >> 4) * 2 + (c >> 5), rr = r & 15, cc = c & 31, ob = rr * 64 + cc * 2; return st * 1024 + (ob ^ (((ob >> 9) & 1) << 5)); }
__host__ __device__ __forceinline__ void stage_rc(int b, int& R, int& C) { const int st = b / 1024, sb = b % 1024, swz = sb ^ (((sb >> 9) & 1) << 5); R = (st >> 1) * 16 + swz / 64; C = (st & 1) * 32 + (swz % 64) / 2; }
__host__ __device__ __forceinline__ int perm32(int rho) { const int n = rho >> 4, i = rho & 15; return 8 * (i >> 2) + 4 * n + (i & 3); }

struct Unit { int pm, pn; };
struct Gemm { const bf16_t* A; const bf16_t* Bt; int M, N, K; };

struct StaticOrder {
    int nM, nN, nwg, G, c;
    __host__ __device__ void init(int M, int N, int G_, int c_) { nM = M / BM; nN = N / BM; nwg = nM * nN; G = G_; c = c_; }
    __host__ __device__ bool next(int i, Unit& u) const {
        const long L = (long)i * G + c; if (L >= nwg) return false;
        int wgid = (int)L; { const int q = nwg / NXCD, r = nwg % NXCD, xcd = wgid % NXCD, off = wgid / NXCD; wgid = (xcd < r ? xcd * (q + 1) : r * (q + 1) + (xcd - r) * q) + off; }
        const int nig = WGM * nN, gid = wgid / nig, fm = gid * WGM, gsz = (nM - fm) < WGM ? (nM - fm) : WGM;
        u.pm = fm + ((wgid % nig) % gsz); u.pn = (wgid % nig) / gsz; return true;
    }
    __device__ __forceinline__ void a_ready(const Unit&) const {}
    __device__ __forceinline__ void done(const Unit&) const {}
};

__device__ __forceinline__ unsigned cvt_pk_bf16(float lo, float hi) { unsigned r; asm volatile("v_cvt_pk_bf16_f32 %0, %1, %2" : "=v"(r) : "v"(lo), "v"(hi)); return r; }
__device__ __forceinline__ float row_rstd16(const float* part, int row) {
    const f32x4* p = (const f32x4*)(part + (size_t)row * 16);
    const f32x4 a = p[0], b = p[1], c = p[2], d = p[3];
    const float s = ((a[0] + a[1]) + (a[2] + a[3])) + ((b[0] + b[1]) + (b[2] + b[3])) + ((c[0] + c[1]) + (c[2] + c[3])) + ((d[0] + d[1]) + (d[2] + d[3]));
    return 1.0f / sqrtf(s * (1.0f / 1024.0f) + 1e-6f);
}
__device__ __forceinline__ int mod_index(int pm) { return pm < 16 ? 0 : 1 + ((pm - 16) >> 3); }

template <int ACT> struct EpiScaleBias {
    static constexpr bool PERM = true, AFTER_DRAIN = false;
    bf16_t* O; int ldc; const float* bias; int ldb; const float* part;
    __device__ __forceinline__ void operator()(const f32x4 (&acc)[2][2][4][2], const Unit& u, int wr, int wc, int fr, int fq) const {
        asm volatile("" : "+v"(fr), "+v"(fq));
        const int row0 = u.pm * BM + wr * 64 + fr; const int col0 = u.pn * BM + wc * 32 + 8 * fq;
        const float* bp = bias + (size_t)mod_index(u.pm) * ldb + col0;
        f32x4 bv[2][2];
#pragma unroll
        for (int bj = 0; bj < 2; ++bj)
#pragma unroll
            for (int n = 0; n < 2; ++n) bv[bj][n] = *(const f32x4*)(bp + bj * HALF + 4 * n);
#pragma unroll
        for (int ai = 0; ai < 2; ++ai)
#pragma unroll
            for (int m = 0; m < 4; ++m) { const int row = row0 + ai * HALF + m * 16; const float rs = row_rstd16(part, row); bf16_t* rowp = O + (size_t)row * ldc + col0;
#pragma unroll
                for (int bj = 0; bj < 2; ++bj) { f32x4 v0 = acc[ai][bj][m][0] * rs + bv[bj][0], v1 = acc[ai][bj][m][1] * rs + bv[bj][1];
                    if (ACT == 1) {
#pragma unroll
                        for (int e = 0; e < 4; ++e) { const float a = fmaxf(v0[e], 0.f), b = fmaxf(v1[e], 0.f); v0[e] = a * a; v1[e] = b * b; } }
                    u32x4 w; w.x = cvt_pk_bf16(v0[0], v0[1]); w.y = cvt_pk_bf16(v0[2], v0[3]); w.z = cvt_pk_bf16(v1[0], v1[1]); w.w = cvt_pk_bf16(v1[2], v1[3]);
                    *(u32x4*)(rowp + bj * HALF) = w; } }
    }
};

struct EpiResid {
    static constexpr bool PERM = false, AFTER_DRAIN = false;
    const float* xinA; const float* xinB;
    float* xout; bf16_t* xs; const float* gate; const float* normg; const float* sc; float* part;
    __device__ __forceinline__ void operator()(const f32x4 (&acc)[2][2][4][2], const Unit& u, int wr, int wc, int fr, int fq) const {
        typedef unsigned u32x2v __attribute__((ext_vector_type(2)));
        asm volatile("" : "+v"(fr), "+v"(fq));
        const int row0 = u.pm * BM + wr * 64 + fr; const int col0 = u.pn * BM + wc * 32 + 4 * fq; const int mi = mod_index(u.pm);
        f32x4 gv[2][2], sv[2][2];
#pragma unroll
        for (int bj = 0; bj < 2; ++bj)
#pragma unroll
            for (int n = 0; n < 2; ++n) { const int c = col0 + bj * HALF + n * 16; gv[bj][n] = *(const f32x4*)(gate + (size_t)mi * 6144 + c);
                if (xs) { const f32x4 g = *(const f32x4*)(normg + c), s = *(const f32x4*)(sc + (size_t)mi * 6144 + c); sv[bj][n] = g * (s + 1.0f); } else sv[bj][n] = (f32x4){0.f, 0.f, 0.f, 0.f}; }
#pragma unroll
        for (int ai = 0; ai < 2; ++ai)
#pragma unroll
            for (int m = 0; m < 4; ++m) { const int row = row0 + ai * HALF + m * 16;
                const float* xr = (row < 4096) ? xinA + (size_t)row * 1024 : xinB + (size_t)(row - 4096) * 1024; float ss = 0.f;
#pragma unroll
                for (int bj = 0; bj < 2; ++bj)
#pragma unroll
                    for (int n = 0; n < 2; ++n) { const int c = col0 + bj * HALF + n * 16; const f32x4 xo = *(const f32x4*)(xr + c); const f32x4 xn = xo + gv[bj][n] * acc[ai][bj][m][n];
                        *(f32x4*)(xout + (size_t)row * 1024 + c) = xn; ss += (xn[0] * xn[0] + xn[1] * xn[1]) + (xn[2] * xn[2] + xn[3] * xn[3]);
                        if (xs) { const f32x4 o = xn * sv[bj][n]; u32x2v w; w.x = cvt_pk_bf16(o[0], o[1]); w.y = cvt_pk_bf16(o[2], o[3]); *(u32x2v*)(xs + (size_t)row * 1024 + c) = w; } }
                ss += __shfl_xor(ss, 16); ss += __shfl_xor(ss, 32);
                if (fq == 0) part[(size_t)row * 16 + u.pn * 4 + wc] = ss; }
    }
};

template <class Epi, class Sched, bool ALIGN_EPI = false, bool SP2 = false>
__device__ __forceinline__ void gemm_phase(PG8_LAS unsigned char* lds, const Gemm g, const Sched& S, const Epi& E, int tid_in) {
    int tid = tid_in; asm volatile("" : "+v"(tid));
    const int wid = __builtin_amdgcn_readfirstlane(tid >> 6), lane = tid & 63, wr = wid >> 2, wc = wid & 3, fr = lane & 15, fq = lane >> 4;
    const int K = g.K, nt = K / BK;
    unsigned voffA[2], voffB[2];
#pragma unroll
    for (int i = 0; i < 2; ++i) { int R, C; stage_rc(tid * 16 + i * 8192, R, C); const int Rb = Epi::PERM ? ((R & ~31) + perm32(R & 31)) : R;
        voffA[i] = (unsigned)(R * K + C) * 2u; voffB[i] = (unsigned)(Rb * K + C) * 2u; }
    const size_t kstep = (size_t)(BK * 2);
    const size_t hstep = (size_t)HALF * K * 2;
    const size_t tstep = 2 * hstep;
    const unsigned ldsw = (unsigned)wid * 1024u;
    const int aoff = lds_byte(wr * 64 + fr, fq * 8), boff = lds_byte(wc * 32 + fr, fq * 8);
#define PG8_SA(b, h) (((b) * 2 + (h)) * HTB)
#define PG8_SB(b, h) ((4 + (b) * 2 + (h)) * HTB)
#define PG8_STAGE(bufoff, gbase, voff) do { _Pragma("unroll") for (int _i = 0; _i < 2; ++_i) \
        __builtin_amdgcn_global_load_lds((const unsigned*)((const char*)(gbase) + (voff)[_i]), (PG8_LAS unsigned*)(lds + (bufoff) + ldsw + _i * 8192), 16, 0, 0); } while (0)
#define PG8_LDA(dst, b, h) do { _Pragma("unroll") for (int m = 0; m < 4; ++m) _Pragma("unroll") for (int k = 0; k < 2; ++k) dst[m][k] = *(const PG8_LAS bf16x8*)(lds + PG8_SA(b, h) + aoff + m * 2048 + k * 1024); } while (0)
#define PG8_LDB(dst, b, h) do { _Pragma("unroll") for (int n = 0; n < 2; ++n) _Pragma("unroll") for (int k = 0; k < 2; ++k) dst[n][k] = *(const PG8_LAS bf16x8*)(lds + PG8_SB(b, h) + boff + n * 2048 + k * 1024); } while (0)
#define PG8_MMA(ai, bj, At, Bt) do { __builtin_amdgcn_s_setprio(1); _Pragma("unroll") for (int m = 0; m < 4; ++m) _Pragma("unroll") for (int n = 0; n < 2; ++n) _Pragma("unroll") for (int k = 0; k < 2; ++k) \
        acc[ai][bj][m][n] = __builtin_amdgcn_mfma_f32_16x16x32_bf16(Bt[n][k], At[m][k], acc[ai][bj][m][n], 0, 0, 0); __builtin_amdgcn_s_setprio(0); } while (0)
#define PG8_WAIT_V(n) asm volatile("s_waitcnt vmcnt(" #n ")" ::: "memory")
#define PG8_WAIT_L(n) asm volatile("s_waitcnt lgkmcnt(" #n ")" ::: "memory")
#define PG8_BAR __builtin_amdgcn_s_barrier()
#define PG8_SCHED __builtin_amdgcn_sched_barrier(0)
    Unit cur, nxt; int ui = 0;
    if (!S.next(0, cur)) return;
    f32x4 acc[2][2][4][2];
#pragma unroll
    for (int a = 0; a < 2; ++a)
#pragma unroll
        for (int b = 0; b < 2; ++b)
#pragma unroll
            for (int m = 0; m < 4; ++m)
#pragma unroll
                for (int n = 0; n < 2; ++n) acc[a][b][m][n] = (f32x4){0.f, 0.f, 0.f, 0.f};
    bf16x8 At[4][2], B0[2][2], B1[2][2];
    const char* cA = (const char*)g.A + (size_t)cur.pm * tstep; const char* cB = (const char*)g.Bt + (size_t)cur.pn * tstep;
    S.a_ready(cur);
    if constexpr (SP2) {
        PG8_STAGE(PG8_SB(0, 0), cB, voffB); PG8_STAGE(PG8_SB(0, 1), cB + hstep, voffB); PG8_STAGE(PG8_SA(0, 0), cA, voffA); PG8_STAGE(PG8_SA(0, 1), cA + hstep, voffA);
        if (wr == 1) PG8_BAR;
        PG8_WAIT_V(2); PG8_BAR;
        PG8_STAGE(PG8_SB(1, 0), cB + kstep, voffB); PG8_STAGE(PG8_SA(1, 0), cA + kstep, voffA); PG8_STAGE(PG8_SB(1, 1), cB + hstep + kstep, voffB);
        PG8_WAIT_V(6); PG8_BAR;
    } else {
        PG8_STAGE(PG8_SB(0, 0), cB, voffB); PG8_STAGE(PG8_SA(0, 0), cA, voffA); PG8_STAGE(PG8_SB(0, 1), cB + hstep, voffB); PG8_STAGE(PG8_SA(0, 1), cA + hstep, voffA);
        if (wr == 1) PG8_BAR;
        PG8_WAIT_V(4); PG8_BAR;
        PG8_STAGE(PG8_SB(1, 0), cB + kstep, voffB); PG8_STAGE(PG8_SA(1, 0), cA + kstep, voffA); PG8_STAGE(PG8_SB(1, 1), cB + hstep + kstep, voffB);
        PG8_WAIT_V(6); PG8_BAR;
    }
    for (;;) {
        const bool has_next = S.next(ui + 1, nxt);
        const char* nA = has_next ? (const char*)g.A + (size_t)nxt.pm * tstep : cA; const char* nB = has_next ? (const char*)g.Bt + (size_t)nxt.pn * tstep : cB;
        for (int t = 0; t < nt; t += 2) {
            const bool last = (t == nt - 2);
            const char* a1 = cA + (size_t)(t + 1) * kstep;
            const char* a2 = last ? nA : cA + (size_t)(t + 2) * kstep; const char* b2 = last ? nB : cB + (size_t)(t + 2) * kstep;
            const char* a3 = a2 + kstep; const char* b3 = b2 + kstep;
            if (last && has_next) S.a_ready(nxt);
            if constexpr (SP2) {
            PG8_LDB(B0, 0, 0); PG8_LDB(B1, 0, 1); PG8_SCHED; PG8_LDA(At, 0, 0); PG8_STAGE(PG8_SA(1, 1), a1 + hstep, voffA);
            PG8_WAIT_V(8); PG8_WAIT_L(0); PG8_BAR; PG8_MMA(0, 0, At, B0); PG8_MMA(0, 1, At, B1); PG8_BAR; PG8_SCHED;
            PG8_LDA(At, 0, 1); PG8_STAGE(PG8_SB(0, 0), b2, voffB); PG8_STAGE(PG8_SB(0, 1), b2 + hstep, voffB); PG8_STAGE(PG8_SA(0, 0), a2, voffA);
            PG8_WAIT_V(8); PG8_WAIT_L(0); PG8_BAR; PG8_MMA(1, 0, At, B0); PG8_MMA(1, 1, At, B1); PG8_BAR; PG8_SCHED;
            PG8_LDB(B0, 1, 0); PG8_LDB(B1, 1, 1); PG8_SCHED; PG8_LDA(At, 1, 0); PG8_STAGE(PG8_SA(0, 1), a2 + hstep, voffA);
            PG8_WAIT_V(8); PG8_WAIT_L(0); PG8_BAR; PG8_MMA(0, 0, At, B0); PG8_MMA(0, 1, At, B1); PG8_BAR; PG8_SCHED;
            PG8_LDA(At, 1, 1); PG8_STAGE(PG8_SB(1, 0), b3, voffB); PG8_STAGE(PG8_SB(1, 1), b3 + hstep, voffB); PG8_STAGE(PG8_SA(1, 0), a3, voffA);
            PG8_WAIT_V(8); PG8_WAIT_L(0); PG8_BAR; PG8_MMA(1, 0, At, B0); PG8_MMA(1, 1, At, B1); PG8_BAR; PG8_SCHED;
            } else {
            PG8_LDB(B0, 0, 0); PG8_SCHED; PG8_LDA(At, 0, 0); PG8_STAGE(PG8_SA(1, 1), a1 + hstep, voffA);
            PG8_WAIT_L(8); PG8_BAR; PG8_WAIT_L(0); PG8_MMA(0, 0, At, B0); PG8_BAR; PG8_SCHED;
            PG8_LDB(B1, 0, 1); PG8_STAGE(PG8_SB(0, 0), b2, voffB);
            PG8_BAR; PG8_WAIT_L(0); PG8_MMA(0, 1, At, B1); PG8_BAR;
            PG8_LDA(At, 0, 1); PG8_STAGE(PG8_SA(0, 0), a2, voffA);
            PG8_BAR; PG8_WAIT_L(0); PG8_MMA(1, 0, At, B0); PG8_BAR; PG8_SCHED;
            PG8_STAGE(PG8_SB(0, 1), b2 + hstep, voffB);
            PG8_WAIT_V(6); PG8_BAR; PG8_MMA(1, 1, At, B1); PG8_BAR;
            PG8_LDB(B0, 1, 0); PG8_SCHED; PG8_LDA(At, 1, 0); PG8_STAGE(PG8_SA(0, 1), a2 + hstep, voffA);
            PG8_WAIT_L(8); PG8_BAR; PG8_WAIT_L(0); PG8_MMA(0, 0, At, B0); PG8_BAR; PG8_SCHED;
            PG8_LDB(B1, 1, 1); PG8_STAGE(PG8_SB(1, 0), b3, voffB);
            PG8_BAR; PG8_WAIT_L(0); PG8_MMA(0, 1, At, B1); PG8_BAR;
            PG8_LDA(At, 1, 1); PG8_STAGE(PG8_SA(1, 0), a3, voffA);
            PG8_BAR; PG8_WAIT_L(0); PG8_MMA(1, 0, At, B0); PG8_BAR; PG8_SCHED;
            PG8_STAGE(PG8_SB(1, 1), b3 + hstep, voffB);
            PG8_WAIT_V(6); PG8_BAR; PG8_MMA(1, 1, At, B1); PG8_BAR;
            }
        }
        if constexpr (ALIGN_EPI) { if (wr == 0) PG8_BAR; }
        if constexpr (!Epi::AFTER_DRAIN) { E(acc, cur, wr, wc, fr, fq); S.done(cur); }
        if (!has_next) break;
#pragma unroll
        for (int a = 0; a < 2; ++a)
#pragma unroll
            for (int b = 0; b < 2; ++b)
#pragma unroll
                for (int m = 0; m < 4; ++m)
#pragma unroll
                    for (int n = 0; n < 2; ++n) acc[a][b][m][n] = (f32x4){0.f, 0.f, 0.f, 0.f};
        cur = nxt; cA = nA; cB = nB; ++ui;
        if constexpr (ALIGN_EPI) { if (wr == 1) PG8_BAR; }
    }
    PG8_WAIT_V(0);
    if constexpr (!ALIGN_EPI) { if (wr == 0) PG8_BAR; }
    PG8_BAR;
    if constexpr (Epi::AFTER_DRAIN) { E.fused(acc, cur, wr, wc, fr, fq, lds, wid, lane); S.done(cur); }
#undef PG8_SA
#undef PG8_SB
#undef PG8_STAGE
#undef PG8_LDA
#undef PG8_LDB
#undef PG8_MMA
#undef PG8_WAIT_V
#undef PG8_WAIT_L
#undef PG8_BAR
#undef PG8_SCHED
}
}
#define GAS __attribute__((address_space(1)))
#define LAS __attribute__((address_space(3)))
typedef unsigned short bf16;
typedef unsigned v4u __attribute__((ext_vector_type(4)));
typedef float f32x4 __attribute__((ext_vector_type(4)));
typedef short bf16x8 __attribute__((ext_vector_type(8)));
typedef GAS unsigned gu32;
typedef GAS unsigned long long gu64;
#define RLX_AGENT __ATOMIC_RELAXED, __HIP_MEMORY_SCOPE_AGENT
#define LDS_WAIT() asm volatile("s_waitcnt lgkmcnt(0)" ::: "memory")
#define VM_WAIT() asm volatile("s_waitcnt vmcnt(0)" ::: "memory")
__device__ __forceinline__ unsigned long long rt() { return __builtin_amdgcn_s_memrealtime(); }
__device__ __forceinline__ unsigned f2bf(float f) { unsigned u = __builtin_bit_cast(unsigned, f); return (u + 0x7fffu + ((u >> 16) & 1u)) >> 16; }
__device__ __forceinline__ unsigned pk2(float lo, float hi) { return f2bf(lo) | (f2bf(hi) << 16); }

#define XB_TMO      128
#define XB_XCNT(j)  (256  + 64 * (j))
#define XB_XSUB(j)  (1280 + 64 * (j))
#define XB_XGEN(j)  (2304 + 64 * (j))
#define XB_TOP      3328
#define XB_TOPGEN   3392
#define XCD_BAR_WORDS 3456
#define XB_SPIN_CAP (1u << 18)

__device__ __forceinline__ unsigned xb_ld(unsigned* p)              { return __hip_atomic_load(p, __ATOMIC_RELAXED, __HIP_MEMORY_SCOPE_AGENT); }
__device__ __forceinline__ unsigned xb_add(unsigned* p, unsigned v) { return __hip_atomic_fetch_add(p, v, __ATOMIC_RELAXED, __HIP_MEMORY_SCOPE_AGENT); }
__device__ __forceinline__ unsigned xb_xcc_id() { return (unsigned)__builtin_amdgcn_s_getreg((3 << 11) | 20) & 0xFu; }
#define XB_SPIN(cond, bar) do { unsigned _sp = 0; while (cond) { __builtin_amdgcn_s_sleep(1); \
    if ((++_sp & 255u) == 0u) { if (xb_ld(&(bar)[XB_TMO])) break; if (_sp > XB_SPIN_CAP) { atomicAdd(&(bar)[XB_TMO], 1u); break; } } } } while (0)

struct XcdBarrier {
    unsigned* bar; unsigned x;
    volatile LAS unsigned* st;
};

__device__ __forceinline__ XcdBarrier xcd_barrier_post(unsigned* bar, volatile LAS unsigned* st) {
    XcdBarrier b; b.bar = bar; b.x = xb_xcc_id(); b.st = st;
    if (threadIdx.x == 0) (void)xb_add(&bar[XB_XCNT(b.x)], 1u);
    return b;
}
__device__ __forceinline__ void xcd_barrier_complete(unsigned* bar, unsigned x, unsigned& nloc, unsigned& nx) {
    const unsigned G = gridDim.x * gridDim.y * gridDim.z;
    unsigned sum, cnt, mine, sp = 0u;
    for (;;) {
        sum = 0u; cnt = 0u; mine = 0u;
#pragma unroll
        for (unsigned j = 0; j < 16; ++j) { const unsigned c = xb_ld(&bar[XB_XCNT(j)]); sum += c; cnt += (c > 0u) ? 1u : 0u; mine = (j == x) ? c : mine; }
        if (sum == G) break;
        __builtin_amdgcn_s_sleep(1);
        if ((++sp & 255u) == 0u) { if (xb_ld(&bar[XB_TMO])) break; if (sp > XB_SPIN_CAP) { atomicAdd(&bar[XB_TMO], 1u); break; } }
    }
    nloc = mine > 0u ? mine : 1u; nx = cnt > 0u ? cnt : 1u;
}

__device__ __forceinline__ void xcd_barrier(const XcdBarrier& b) {
    asm volatile("s_waitcnt vmcnt(0)" ::: "memory");
    __syncthreads();
    if (threadIdx.x == 0) {
        unsigned* bar = b.bar;
        __builtin_amdgcn_s_waitcnt(0);
        unsigned nloc = b.st[0], nx = b.st[1];
        if (nloc == 0u) { xcd_barrier_complete(bar, b.x, nloc, nx); b.st[0] = nloc; b.st[1] = nx; }
        const unsigned old = xb_add(&bar[XB_XSUB(b.x)], 1u);
        const unsigned gen = old / nloc;
        if (old + 1u == (gen + 1u) * nloc) {
            __builtin_amdgcn_fence(__ATOMIC_RELEASE, "agent");
            asm volatile("s_waitcnt vmcnt(0)" ::: "memory");
            const unsigned og = xb_add(&bar[XB_TOP], 1u);
            const unsigned tg = og / nx;
            if (og + 1u == (tg + 1u) * nx) xb_add(&bar[XB_TOPGEN], 1u);
            else XB_SPIN(xb_ld(&bar[XB_TOPGEN]) == tg, bar);
            __builtin_amdgcn_fence(__ATOMIC_ACQUIRE, "agent");
            xb_add(&bar[XB_XGEN(b.x)], 1u);
            asm volatile("s_waitcnt vmcnt(0)" ::: "memory");
        } else {
            XB_SPIN(xb_ld(&bar[XB_XGEN(b.x)]) == gen, bar);
            __builtin_amdgcn_fence(__ATOMIC_ACQUIRE, "agent");
            asm volatile("s_waitcnt vmcnt(0)" ::: "memory");
        }
    }
    __syncthreads();
}
namespace mk {
typedef float f32x16 __attribute__((ext_vector_type(16)));
typedef float f32x2_t __attribute__((ext_vector_type(2)));
typedef __bf16 bf16x2_t __attribute__((ext_vector_type(2)));

constexpr int DM = 1024, M_CTX = 4096, MT = 12288, NL = 4, NPROJP = 2048, DFF = 4096, NGT = 384, GT_LAT0 = 128;
constexpr float EPS = 1e-6f, LOG2E = 1.4426950408889634f, NEGBIG = -1e30f;
constexpr int C_NAQ = 0, C_NAK = 256, C_NAV = 512, C_POOL = 768, C_CQ = 1024, C_CKV = 1280, C_KPE = 1408, C_SQ = 1440, C_SK = 1696, C_SV = 1824;

constexpr size_t MiB = 1u << 20;
constexpr size_t WS_CTL = 0, CTL_ZERO_BYTES = 64 * 1024;
constexpr size_t WS_TAB = 1 * MiB;
constexpr size_t WS_MOD = 2 * MiB;
constexpr size_t WS_BA = 3 * MiB;
constexpr size_t WS_BD = 4 * MiB;
constexpr size_t WS_PARTA = 5 * MiB;
constexpr size_t WS_PARTD = 6 * MiB;
constexpr size_t WS_WUQ = 7 * MiB;
constexpr size_t WS_WUKV = 8 * MiB;
constexpr size_t WS_WPOOL = 9 * MiB;
constexpr size_t WS_WIN = 10 * MiB;
constexpr size_t WS_WOUT = 26 * MiB;
constexpr size_t WS_W1 = 34 * MiB;
constexpr size_t WS_W2 = 66 * MiB;
constexpr size_t WS_CKNA = 98 * MiB;
constexpr size_t WS_CVNA = 102 * MiB;
constexpr size_t WS_CKS = 106 * MiB;
constexpr size_t WS_CVS = 108 * MiB;
constexpr size_t WS_CKM = 110 * MiB;
constexpr size_t WS_CVM = 116 * MiB;
constexpr size_t WS_X = 120 * MiB;
constexpr size_t WS_XS = 168 * MiB;
constexpr size_t WS_MIX = 192 * MiB;
constexpr size_t WS_P = 216 * MiB;
constexpr size_t WS_QNA = 264 * MiB;
constexpr size_t WS_KNA = 270 * MiB;
constexpr size_t WS_VNA = 276 * MiB;
constexpr size_t WS_QM = 282 * MiB;
constexpr size_t WS_KM = 291 * MiB;
constexpr size_t WS_VM = 300 * MiB;
constexpr size_t WS_QS = 306 * MiB;
constexpr size_t WS_KS = 312 * MiB;
constexpr size_t WS_VS = 315 * MiB;
constexpr size_t WS_Z = 216 * MiB;
constexpr size_t WS_END = 318 * MiB;

constexpr size_t O_Y = 0, O_NAK = 12582912, O_NAV = 16777216, O_CKV = 20971520, O_KPE = 23068672, O_SK = 23592960, O_SV = 25690112;

struct Args { const float* in[32]; float* out; unsigned char* ws; };

__device__ __forceinline__ unsigned cvtpk(float lo, float hi) { f32x2_t v = {lo, hi}; bf16x2_t b = __builtin_convertvector(v, bf16x2_t); return __builtin_bit_cast(unsigned, b); }
__device__ __forceinline__ float bflo(unsigned w) { return __uint_as_float(w << 16); }
__device__ __forceinline__ float bfhi(unsigned w) { return __uint_as_float(w & 0xffff0000u); }
__device__ __forceinline__ int swz(int x) { return (x & ~12) | ((x & 4) << 1) | ((x & 8) >> 1); }
__device__ __forceinline__ f32x16 mfma32(bf16x8 a, bf16x8 b, f32x16 c) { return __builtin_amdgcn_mfma_f32_32x32x16_bf16(a, b, c, 0, 0, 0); }
__device__ __forceinline__ bf16x8 pack8(float a0, float a1, float a2, float a3, float a4, float a5, float a6, float a7) {
    v4u w; w.x = cvtpk(a0, a1); w.y = cvtpk(a2, a3); w.z = cvtpk(a4, a5); w.w = cvtpk(a6, a7); return __builtin_bit_cast(bf16x8, w); }
#define PACK8ARR(a, o) pack8((a)[(o)], (a)[(o) + 1], (a)[(o) + 2], (a)[(o) + 3], (a)[(o) + 4], (a)[(o) + 5], (a)[(o) + 6], (a)[(o) + 7])
template <bool F32> __device__ __forceinline__ void load8(const void* base, size_t elem, float (&f)[8]) {
    if (F32) { const f32x4* p = (const f32x4*)((const float*)base + elem); const f32x4 a = p[0], b = p[1];
        f[0] = a[0]; f[1] = a[1]; f[2] = a[2]; f[3] = a[3]; f[4] = b[0]; f[5] = b[1]; f[6] = b[2]; f[7] = b[3]; }
    else { const v4u w = *(const v4u*)((const bf16*)base + elem);
        f[0] = bflo(w.x); f[1] = bfhi(w.x); f[2] = bflo(w.y); f[3] = bfhi(w.y); f[4] = bflo(w.z); f[5] = bfhi(w.z); f[6] = bflo(w.w); f[7] = bfhi(w.w); }
}
__device__ __forceinline__ void store8f(float* p, const float (&f)[8]) { ((f32x4*)p)[0] = (f32x4){f[0], f[1], f[2], f[3]}; ((f32x4*)p)[1] = (f32x4){f[4], f[5], f[6], f[7]}; }

struct TokInfo { int lat; int b; int t; };
__device__ __forceinline__ TokInfo tok_info(int row) { TokInfo r; if (row < M_CTX) { r.lat = 0; r.b = row >> 8; r.t = row & 255; } else { r.lat = 1; r.b = (row - M_CTX) >> 11; r.t = (row - M_CTX) & 2047; } return r; }


template <bool F32, bool NORM>
__device__ __forceinline__ void head_norm_task(const void* src, size_t pitch, int row0, int col, const float* gain, bool isK,
                                               const float* ropeS, int prow, int pcol, bf16* dst  , int tile, float* fout  , int lane) {
    const int tok = lane & 31;
    float v[64];
#pragma unroll
    for (int c = 0; c < 8; ++c) { float f[8]; load8<F32>(src, (size_t)(row0 + tok) * pitch + col + 8 * c, f);
#pragma unroll
        for (int e = 0; e < 8; ++e) v[8 * c + e] = f[e]; }
    if (NORM) {
        float ss = 0.f;
#pragma unroll
        for (int d = 0; d < 64; ++d) ss += v[d] * v[d];
        const float rs = 1.0f / sqrtf(ss * (1.0f / 64.0f) + EPS);
#pragma unroll
        for (int d = 0; d < 64; ++d) v[d] = v[d] * rs * gain[d];
    }
    if (fout) {
#pragma unroll
        for (int c = 0; c < 16; ++c) ((f32x4*)fout)[c] = (f32x4){v[4 * c], v[4 * c + 1], v[4 * c + 2], v[4 * c + 3]};
    }
    if (ropeS) {
#pragma unroll
        for (int i = 0; i < 16; ++i) {
            const float cr = ropeS[prow * 16 + i], sr = ropeS[1024 + prow * 16 + i], cc = ropeS[pcol * 16 + i], sc = ropeS[1024 + pcol * 16 + i];
            const float a1 = v[i], a2 = v[16 + i], b1 = v[32 + i], b2 = v[48 + i];
            v[i] = a1 * cr - a2 * sr; v[16 + i] = a1 * sr + a2 * cr; v[32 + i] = b1 * cc - b2 * sc; v[48 + i] = b1 * sc + b2 * cc;
        }
    }
    const int slot = isK ? swz(tok) : tok;
    bf16* d0 = dst + (size_t)tile * 2048;
#pragma unroll
    for (int c = 0; c < 4; ++c)
#pragma unroll
        for (int hf = 0; hf < 2; ++hf) *(bf16x8*)(d0 + c * 512 + (hf * 32 + slot) * 8) = PACK8ARR(v, 16 * c + 8 * hf);
}

template <bool F32>
__device__ __forceinline__ void vtrans_task(const void* src, size_t pitch, int row0, int col, bf16* dst  , int tile, float* fout, int fpitch, int lane) {
    const int i = lane & 31, kh = lane >> 5; const int tokp = swz(i);
    bf16x8 af[4];
#pragma unroll
    for (int kc = 0; kc < 4; ++kc) { float f[8]; load8<F32>(src, (size_t)(row0 + tokp) * pitch + col + 16 * kc + 8 * kh, f);
        if (fout) store8f(fout + (size_t)tokp * fpitch + 16 * kc + 8 * kh, f);
        af[kc] = PACK8ARR(f, 0); }
    v4u i0 = {0u, 0u, 0u, 0u}, i1 = {0u, 0u, 0u, 0u};
    { const int j0 = i - 8 * kh; const int j1 = i - 16 - 8 * kh;
      unsigned w0[4] = {0u, 0u, 0u, 0u}, w1[4] = {0u, 0u, 0u, 0u};
#pragma unroll
      for (int j = 0; j < 8; ++j) { const unsigned one = 0x3F80u << (16 * (j & 1)); if (j0 == j) w0[j >> 1] |= one; if (j1 == j) w1[j >> 1] |= one; }
      i0 = (v4u){w0[0], w0[1], w0[2], w0[3]}; i1 = (v4u){w1[0], w1[1], w1[2], w1[3]}; }
    const bf16x8 I0 = __builtin_bit_cast(bf16x8, i0), I1 = __builtin_bit_cast(bf16x8, i1);
    bf16* d0 = dst + (size_t)tile * 2048;
#pragma unroll
    for (int ft = 0; ft < 2; ++ft) {
        f32x16 acc = {0.f, 0.f, 0.f, 0.f, 0.f, 0.f, 0.f, 0.f, 0.f, 0.f, 0.f, 0.f, 0.f, 0.f, 0.f, 0.f};
        acc = mfma32(af[2 * ft], I0, acc); acc = mfma32(af[2 * ft + 1], I1, acc);
#pragma unroll
        for (int s = 0; s < 2; ++s) *(bf16x8*)(d0 + ((ft * 2 + s) * 64 + lane) * 8) = PACK8ARR(acc, 8 * s);
    }
}

__device__ __forceinline__ void rope_tail32(float (&t0)[8], float (&t1)[8], const float* ropeM, int prow, int pcol, int h2) {
#pragma unroll
    for (int e = 0; e < 8; ++e) {
        const float p0 = __shfl_xor(t0[e], 32), p1 = __shfl_xor(t1[e], 32);
        const float cr = ropeM[prow * 8 + e], sr = ropeM[512 + prow * 8 + e], cc = ropeM[pcol * 8 + e], sc = ropeM[512 + pcol * 8 + e];
        t0[e] = t0[e] * cr + (h2 ? p0 : -p0) * sr;
        t1[e] = t1[e] * cc + (h2 ? p1 : -p1) * sc;
    }
}

__device__ __forceinline__ void mla_q_task(const bf16* P, int row0, const float* ga  , const bf16* wuqT  , int head, const float* gq  ,
                                           const float* ropeM, bf16* dst  , int tile, int lane) {
    const int tok = lane & 31, kh = lane >> 5; const int row = row0 + tok;
    bf16x8 bfr[16]; float ss = 0.f;
#pragma unroll
    for (int kc = 0; kc < 16; ++kc) { float f[8]; load8<false>(P, (size_t)row * NPROJP + C_CQ + 16 * kc + 8 * kh, f);
#pragma unroll
        for (int e = 0; e < 8; ++e) ss += f[e] * f[e]; }
    ss += __shfl_xor(ss, 32);
    {
        const float rs = 1.0f / sqrtf(ss * (1.0f / 256.0f) + EPS);
        __builtin_amdgcn_sched_barrier(0);
#pragma unroll
        for (int kc = 0; kc < 16; ++kc) { float f[8]; load8<false>(P, (size_t)row * NPROJP + C_CQ + 16 * kc + 8 * kh, f);
            const f32x4 g0 = *(const f32x4*)(ga + 16 * kc + 8 * kh), g1 = *(const f32x4*)(ga + 16 * kc + 8 * kh + 4);
            bfr[kc] = pack8(f[0] * rs * g0[0], f[1] * rs * g0[1], f[2] * rs * g0[2], f[3] * rs * g0[3], f[4] * rs * g1[0], f[5] * rs * g1[1], f[6] * rs * g1[2], f[7] * rs * g1[3]); }
        __builtin_amdgcn_sched_barrier(0);
    }
    f32x16 acc[3];
#pragma unroll
    for (int ft = 0; ft < 3; ++ft) {
        acc[ft] = (f32x16){0.f, 0.f, 0.f, 0.f, 0.f, 0.f, 0.f, 0.f, 0.f, 0.f, 0.f, 0.f, 0.f, 0.f, 0.f, 0.f};
        const bf16* wr = wuqT + (size_t)(head * 96 + 32 * ft + swz(tok)) * 256 + 8 * kh;
#pragma unroll
        for (int kc = 0; kc < 16; ++kc) acc[ft] = mfma32(*(const bf16x8*)(wr + 16 * kc), bfr[kc], acc[ft]);
    }
    float s2 = 0.f;
#pragma unroll
    for (int ft = 0; ft < 3; ++ft)
#pragma unroll
        for (int r = 0; r < 16; ++r) s2 += acc[ft][r] * acc[ft][r];
    s2 += __shfl_xor(s2, 32);
    const float rq = 1.0f / sqrtf(s2 * (1.0f / 96.0f) + EPS);
    const TokInfo ti = tok_info(row);
    bf16* d0 = dst + (size_t)tile * 3072;
#pragma unroll
    for (int ft = 0; ft < 3; ++ft) {
        float o0[8], o1[8];
        const f32x4 ga0 = *(const f32x4*)(gq + 32 * ft + 8 * kh), ga1 = *(const f32x4*)(gq + 32 * ft + 8 * kh + 4), gb0 = *(const f32x4*)(gq + 32 * ft + 16 + 8 * kh), gb1 = *(const f32x4*)(gq + 32 * ft + 16 + 8 * kh + 4);
#pragma unroll
        for (int e = 0; e < 4; ++e) { o0[e] = acc[ft][e] * rq * ga0[e]; o0[4 + e] = acc[ft][4 + e] * rq * ga1[e]; o1[e] = acc[ft][8 + e] * rq * gb0[e]; o1[4 + e] = acc[ft][12 + e] * rq * gb1[e]; }
        if (ft == 2 && ti.lat) rope_tail32(o0, o1, ropeM, ti.t >> 6, ti.t & 63, kh);
        *(bf16x8*)(d0 + (2 * ft) * 512 + (kh * 32 + tok) * 8) = PACK8ARR(o0, 0);
        *(bf16x8*)(d0 + (2 * ft + 1) * 512 + (kh * 32 + tok) * 8) = PACK8ARR(o1, 0);
    }
}

template <bool F32, bool NORM>
__device__ __forceinline__ void mla_kv_task(const void* ckv_src, size_t ckv_pitch, size_t ckv_col, const void* kpe_src, size_t kpe_pitch, size_t kpe_col, int row0,
                                            const float* gkv  , const bf16* wukvT  , int head, const float* gk  , const float* ropeM, int seq_t0  ,
                                            bf16* kdst  , bf16* vdst  , int tile, float* ckv_out, float* kpe_out, int lane) {
    const int tok = lane & 31, kh = lane >> 5; const int row = row0 + tok;
    bf16x8 bfr[8];
    {
        float cv[8][8]; float ss = 0.f;
#pragma unroll
        for (int kc = 0; kc < 8; ++kc) { load8<F32>(ckv_src, (size_t)row * ckv_pitch + ckv_col + 16 * kc + 8 * kh, cv[kc]);
#pragma unroll
            for (int e = 0; e < 8; ++e) ss += cv[kc][e] * cv[kc][e]; }
        if (NORM) {
            ss += __shfl_xor(ss, 32);
            const float rs = 1.0f / sqrtf(ss * (1.0f / 128.0f) + EPS);
#pragma unroll
            for (int kc = 0; kc < 8; ++kc) { const f32x4 g0 = *(const f32x4*)(gkv + 16 * kc + 8 * kh), g1 = *(const f32x4*)(gkv + 16 * kc + 8 * kh + 4);
#pragma unroll
                for (int e = 0; e < 4; ++e) { cv[kc][e] = cv[kc][e] * rs * g0[e]; cv[kc][4 + e] = cv[kc][4 + e] * rs * g1[e]; } }
        }
#pragma unroll
        for (int kc = 0; kc < 8; ++kc) { if (ckv_out) store8f(ckv_out + (size_t)tok * 128 + 16 * kc + 8 * kh, cv[kc]); bfr[kc] = PACK8ARR(cv[kc], 0); }
    }
    __builtin_amdgcn_sched_barrier(0);
    f32x16 an[2];
#pragma unroll
    for (int ft = 0; ft < 2; ++ft) {
        an[ft] = (f32x16){0.f, 0.f, 0.f, 0.f, 0.f, 0.f, 0.f, 0.f, 0.f, 0.f, 0.f, 0.f, 0.f, 0.f, 0.f, 0.f};
        const bf16* wr = wukvT + (size_t)(head * 128 + 32 * ft + swz(tok)) * 128 + 8 * kh;
#pragma unroll
        for (int kc = 0; kc < 8; ++kc) an[ft] = mfma32(*(const bf16x8*)(wr + 16 * kc), bfr[kc], an[ft]);
    }
    __builtin_amdgcn_sched_barrier(0);
    float t0[8], t1[8];
    load8<F32>(kpe_src, (size_t)row * kpe_pitch + kpe_col + 8 * kh, t0);
    load8<F32>(kpe_src, (size_t)row * kpe_pitch + kpe_col + 16 + 8 * kh, t1);
    if (kpe_out) { store8f(kpe_out + (size_t)tok * 32 + 8 * kh, t0); store8f(kpe_out + (size_t)tok * 32 + 16 + 8 * kh, t1); }
    float s2 = 0.f;
#pragma unroll
    for (int ft = 0; ft < 2; ++ft)
#pragma unroll
        for (int r = 0; r < 16; ++r) s2 += an[ft][r] * an[ft][r];
#pragma unroll
    for (int e = 0; e < 8; ++e) s2 += t0[e] * t0[e] + t1[e] * t1[e];
    s2 += __shfl_xor(s2, 32);
    const float rk = 1.0f / sqrtf(s2 * (1.0f / 96.0f) + EPS);
    const int slot = kh * 32 + swz(tok);
    bf16* kd = kdst + (size_t)tile * 3072;
#pragma unroll
    for (int ft = 0; ft < 2; ++ft) {
        float o0[8], o1[8];
        const f32x4 ga0 = *(const f32x4*)(gk + 32 * ft + 8 * kh), ga1 = *(const f32x4*)(gk + 32 * ft + 8 * kh + 4), gb0 = *(const f32x4*)(gk + 32 * ft + 16 + 8 * kh), gb1 = *(const f32x4*)(gk + 32 * ft + 16 + 8 * kh + 4);
#pragma unroll
        for (int e = 0; e < 4; ++e) { o0[e] = an[ft][e] * rk * ga0[e]; o0[4 + e] = an[ft][4 + e] * rk * ga1[e]; o1[e] = an[ft][8 + e] * rk * gb0[e]; o1[4 + e] = an[ft][12 + e] * rk * gb1[e]; }
        *(bf16x8*)(kd + (2 * ft) * 512 + slot * 8) = PACK8ARR(o0, 0);
        *(bf16x8*)(kd + (2 * ft + 1) * 512 + slot * 8) = PACK8ARR(o1, 0);
    }
    {
        const f32x4 ga0 = *(const f32x4*)(gk + 64 + 8 * kh), ga1 = *(const f32x4*)(gk + 64 + 8 * kh + 4), gb0 = *(const f32x4*)(gk + 80 + 8 * kh), gb1 = *(const f32x4*)(gk + 80 + 8 * kh + 4);
#pragma unroll
        for (int e = 0; e < 4; ++e) { t0[e] = t0[e] * rk * ga0[e]; t0[4 + e] = t0[4 + e] * rk * ga1[e]; t1[e] = t1[e] * rk * gb0[e]; t1[4 + e] = t1[4 + e] * rk * gb1[e]; }
        if (ropeM) { const int t = seq_t0 + tok; rope_tail32(t0, t1, ropeM, t >> 6, t & 63, kh); }
        *(bf16x8*)(kd + 4 * 512 + slot * 8) = PACK8ARR(t0, 0);
        *(bf16x8*)(kd + 5 * 512 + slot * 8) = PACK8ARR(t1, 0);
    }
    __builtin_amdgcn_sched_barrier(0);
    bf16x8 afr[8];
    { const int srcl = kh * 32 + swz(tok);
#pragma unroll
      for (int kc = 0; kc < 8; ++kc) { const v4u w = __builtin_bit_cast(v4u, bfr[kc]); v4u o;
          o.x = (unsigned)__shfl((int)w.x, srcl); o.y = (unsigned)__shfl((int)w.y, srcl); o.z = (unsigned)__shfl((int)w.z, srcl); o.w = (unsigned)__shfl((int)w.w, srcl);
          afr[kc] = __builtin_bit_cast(bf16x8, o); } }
    bf16* vd = vdst + (size_t)tile * 2048;
#pragma unroll
    for (int dvt = 0; dvt < 2; ++dvt) {
        f32x16 av = {0.f, 0.f, 0.f, 0.f, 0.f, 0.f, 0.f, 0.f, 0.f, 0.f, 0.f, 0.f, 0.f, 0.f, 0.f, 0.f};
        const bf16* wr = wukvT + (size_t)(head * 128 + 64 + 32 * dvt + tok) * 128 + 8 * kh;
#pragma unroll
        for (int kc = 0; kc < 8; ++kc) av = mfma32(afr[kc], *(const bf16x8*)(wr + 16 * kc), av);
#pragma unroll
        for (int s = 0; s < 2; ++s) *(bf16x8*)(vd + ((dvt * 2 + s) * 64 + lane) * 8) = PACK8ARR(av, 8 * s);
    }
}

template <int DKC, int MODE>
__device__ __forceinline__ void attn_range(float& m, float& l, f32x16& o0, f32x16& o1, const bf16x8 (&qf)[DKC], const bf16* Kb, const bf16* Vb, int ta, int tb, int lane, float sc2,
                                           int seqtile0, int tq, const LAS float* rpb_h) {
    const int hh = lane >> 5;
    bf16x8 kf[DKC];
    { const bf16x8* kp = (const bf16x8*)(Kb + (size_t)ta * (DKC * 512)) + lane;
#pragma unroll
      for (int c = 0; c < DKC; ++c) kf[c] = kp[c * 64]; }
    for (int t = ta; t < tb; ++t) {
        f32x16 s = {0.f, 0.f, 0.f, 0.f, 0.f, 0.f, 0.f, 0.f, 0.f, 0.f, 0.f, 0.f, 0.f, 0.f, 0.f, 0.f};
#pragma unroll
        for (int c = 0; c < DKC; ++c) s = mfma32(kf[c], qf[c], s);
        const bf16x8* vp = (const bf16x8*)(Vb + (size_t)t * 2048) + lane;
        const bf16x8 v00 = vp[0], v01 = vp[64], v10 = vp[128], v11 = vp[192];
        { const int tn = (t + 1 < tb) ? t + 1 : t; const bf16x8* kp = (const bf16x8*)(Kb + (size_t)tn * (DKC * 512)) + lane;
#pragma unroll
          for (int c = 0; c < DKC; ++c) kf[c] = kp[c * 64]; }
        float p[16];
#pragma unroll
        for (int r = 0; r < 16; ++r) p[r] = s[r] * sc2;
        if (MODE == 1) {
            const int rel = t - seqtile0, kr = rel >> 1, kcb = rel & 1; const int qr = tq >> 6, qc = tq & 63;
            int cs = qc - 8; cs = cs < 0 ? 0 : (cs > 48 ? 48 : cs);
            const int dr = kr - qr + 7;
#pragma unroll
            for (int r = 0; r < 16; ++r) { const int kc = 32 * kcb + 16 * (r >> 3) + 8 * hh + (r & 7); const bool valid = (kc >= cs) && (kc < cs + 16);
                int dc = kc - qc + 15; dc = dc < 0 ? 0 : (dc > 30 ? 30 : dc);
                const float bias = rpb_h[dr * 31 + dc]; p[r] = valid ? p[r] + bias : NEGBIG; }
        } else if (MODE == 2) {
            const int sb = (t - seqtile0) * 32 + 8 * hh - tq;
#pragma unroll
            for (int r = 0; r < 16; ++r) { const int d = sb + 16 * (r >> 3) + (r & 7); p[r] = (d <= 128 && d >= -128) ? p[r] : NEGBIG; }
        }
        float mx = p[0];
#pragma unroll
        for (int r = 1; r < 16; ++r) mx = fmaxf(mx, p[r]);
        mx = fmaxf(mx, __shfl_xor(mx, 32));
        const float mn = fmaxf(m, mx); const float alpha = __builtin_amdgcn_exp2f(m - mn); m = mn;
        float sum = 0.f;
#pragma unroll
        for (int r = 0; r < 16; ++r) { p[r] = __builtin_amdgcn_exp2f(p[r] - mn); sum += p[r]; }
        l = l * alpha + sum;
#pragma unroll
        for (int r = 0; r < 16; ++r) { o0[r] *= alpha; o1[r] *= alpha; }
        const bf16x8 pf0 = PACK8ARR(p, 0), pf1 = PACK8ARR(p, 8);
        o0 = mfma32(v00, pf0, o0); o0 = mfma32(v01, pf1, o0);
        o1 = mfma32(v10, pf0, o1); o1 = mfma32(v11, pf1, o1);
    }
}

__device__ __forceinline__ void attn_store(float m, float l, const f32x16& o0, const f32x16& o1, bool has_sink, float sinkv, bf16* mix_row  , int lane) {
    typedef unsigned u32x2v __attribute__((ext_vector_type(2)));
    const int hh = lane >> 5;
    float lt = l + __shfl_xor(l, 32);
    if (has_sink) lt += __builtin_amdgcn_exp2f(sinkv * LOG2E - m);
    const float inv = 1.0f / lt;
#pragma unroll
    for (int g = 0; g < 4; ++g) {
        u32x2v w0, w1;
        w0.x = cvtpk(o0[4 * g] * inv, o0[4 * g + 1] * inv); w0.y = cvtpk(o0[4 * g + 2] * inv, o0[4 * g + 3] * inv);
        w1.x = cvtpk(o1[4 * g] * inv, o1[4 * g + 1] * inv); w1.y = cvtpk(o1[4 * g + 2] * inv, o1[4 * g + 3] * inv);
        *(u32x2v*)(mix_row + 8 * g + 4 * hh) = w0;
        *(u32x2v*)(mix_row + 32 + 8 * g + 4 * hh) = w1;
    }
}

template <int DKC> __device__ __forceinline__ void load_q(bf16x8 (&qf)[DKC], const bf16* Qb  , int tile, int lane) {
    const bf16x8* qp = (const bf16x8*)(Qb + (size_t)tile * (DKC * 512)) + lane;
#pragma unroll
    for (int c = 0; c < DKC; ++c) qf[c] = qp[c * 64];
}

}
namespace mk {
constexpr int NWAVES = 8, NTHR = 512;
constexpr int RING_BYTES = 131072, LDSCTL_OFF = RING_BYTES, LDS_BYTES = 147456;

__device__ __forceinline__ float wave_sum(float v) {
#pragma unroll
    for (int o = 1; o < 64; o <<= 1) v += __shfl_xor(v, o);
    return v;
}

__device__ __forceinline__ void transpose_item(const float* W, int K, int N, bf16* WT, int row_off, LAS float* scr, int item, int lane) {
    const int nblk = N / 32, kb = item / nblk, nb = item % nblk, k0 = 64 * kb, n0 = 32 * nb;
#pragma unroll 8
    for (int i = 0; i < 32; ++i) { const int kk = 2 * i + (lane >> 5); scr[kk * 33 + (lane & 31)] = W[(size_t)(k0 + kk) * N + n0 + (lane & 31)]; }
    asm volatile("s_waitcnt lgkmcnt(0)" ::: "memory");
    const int c = lane & 7;
#pragma unroll
    for (int j = 0; j < 4; ++j) { const int n = (lane >> 3) + 8 * j; const LAS float* s = scr + (8 * c) * 33 + n;
        v4u o; o.x = cvtpk(s[0 * 33], s[1 * 33]); o.y = cvtpk(s[2 * 33], s[3 * 33]); o.z = cvtpk(s[4 * 33], s[5 * 33]); o.w = cvtpk(s[6 * 33], s[7 * 33]);
        *(v4u*)(WT + (size_t)(row_off + n0 + n) * K + k0 + 8 * c) = o; }
    asm volatile("s_waitcnt lgkmcnt(0)" ::: "memory");
}

__device__ __forceinline__ void gemv5_item(const float* W, int N, int c0, const LAS float* vec, LAS float* red, float* out, int ldo, const float* bias, int tid) {
    const int kg = tid >> 6, j = tid & 63, col = c0 + j; const bool ok = col < N;
    float a0 = 0.f, a1 = 0.f, a2 = 0.f, a3 = 0.f, a4 = 0.f;
    const float* wp = W + (size_t)(kg * 128) * N + (ok ? col : 0);
#pragma unroll 8
    for (int k = 0; k < 128; ++k) { const float w = wp[(size_t)k * N]; const int kk = kg * 128 + k;
        a0 += vec[kk] * w; a1 += vec[1024 + kk] * w; a2 += vec[2048 + kk] * w; a3 += vec[3072 + kk] * w; a4 += vec[4096 + kk] * w; }
    red[(kg * 5 + 0) * 64 + j] = a0; red[(kg * 5 + 1) * 64 + j] = a1; red[(kg * 5 + 2) * 64 + j] = a2; red[(kg * 5 + 3) * 64 + j] = a3; red[(kg * 5 + 4) * 64 + j] = a4;
    __syncthreads();
    if (tid < 320) { const int mi = tid >> 6; float s = 0.f;
#pragma unroll
        for (int g = 0; g < 8; ++g) s += red[(g * 5 + mi) * 64 + j];
        if (ok) out[(size_t)mi * ldo + col] = s + (bias ? bias[col] : 0.f); }
    __syncthreads();
}

__device__ __forceinline__ int lane_id_asm() { int r; asm volatile("v_mbcnt_lo_u32_b32 %0, -1, 0\n\tv_mbcnt_hi_u32_b32 %0, -1, %0" : "=v"(r)); return r; }
typedef __attribute__((address_space(4))) const Args* ArgsP;
#define PHASE_PTRS ArgsP a = ap; asm volatile("" : "+s"(a)); unsigned char* const ws = a->ws; float* const out = a->out; (void)ws; (void)out; \
    int tid = wave_s * 64 + lane_id_asm(); asm volatile("" : "+v"(tid)); const int lane = tid & 63, wave = __builtin_amdgcn_readfirstlane(tid >> 6); const int gw = bid * NWAVES + wave, NGW = G * NWAVES; (void)lane; (void)gw; (void)NGW;
#define x_prompt (a->in[0])
#define x_sample (a->in[1])
#define cache_na_k (a->in[2])
#define cache_na_v (a->in[3])
#define cache_ckv (a->in[4])
#define cache_kpe (a->in[5])
#define cache_swa_k (a->in[6])
#define cache_swa_v (a->in[7])
#define cond_in (a->in[8])
#define c_ctx (a->in[9])
#define norm1 (a->in[10])
#define norm2 (a->in[11])
#define w_ada (a->in[12])
#define b_ada (a->in[13])
#define w_in (a->in[14])
#define w_out (a->in[15])
#define na_q_norm (a->in[16])
#define na_k_norm (a->in[17])
#define na_rpb (a->in[18])
#define pool_w (a->in[19])
#define pool_scale (a->in[20])
#define mla_q_a_norm (a->in[21])
#define mla_w_uq (a->in[22])
#define mla_kv_norm (a->in[23])
#define mla_w_ukv (a->in[24])
#define mla_q_norm (a->in[25])
#define mla_k_norm (a->in[26])
#define swa_q_norm (a->in[27])
#define swa_k_norm (a->in[28])
#define swa_sink (a->in[29])
#define mlp_w1 (a->in[30])
#define mlp_w2 (a->in[31])
#define TAB ((float*)(ws + WS_TAB))
#define MOD ((float*)(ws + WS_MOD))
#define BA ((float*)(ws + WS_BA))
#define BD ((float*)(ws + WS_BD))
#define PARTA ((float*)(ws + WS_PARTA))
#define PARTD ((float*)(ws + WS_PARTD))
#define WUQ ((bf16*)(ws + WS_WUQ))
#define WUKV ((bf16*)(ws + WS_WUKV))
#define WPOOL ((bf16*)(ws + WS_WPOOL))
#define WIN ((bf16*)(ws + WS_WIN))
#define WOUT ((bf16*)(ws + WS_WOUT))
#define W1B ((bf16*)(ws + WS_W1))
#define W2B ((bf16*)(ws + WS_W2))
#define CKNA ((bf16*)(ws + WS_CKNA))
#define CVNA ((bf16*)(ws + WS_CVNA))
#define CKS ((bf16*)(ws + WS_CKS))
#define CVS ((bf16*)(ws + WS_CVS))
#define CKM ((bf16*)(ws + WS_CKM))
#define CVM ((bf16*)(ws + WS_CVM))
#define XB ((float*)(ws + WS_X))
#define XS ((bf16*)(ws + WS_XS))
#define MIX ((bf16*)(ws + WS_MIX))
#define PB ((bf16*)(ws + WS_P))
#define ZB ((bf16*)(ws + WS_Z))
#define QNA ((bf16*)(ws + WS_QNA))
#define KNA ((bf16*)(ws + WS_KNA))
#define VNA ((bf16*)(ws + WS_VNA))
#define QM ((bf16*)(ws + WS_QM))
#define KM ((bf16*)(ws + WS_KM))
#define VM ((bf16*)(ws + WS_VM))
#define QS ((bf16*)(ws + WS_QS))
#define KS ((bf16*)(ws + WS_KS))
#define VS ((bf16*)(ws + WS_VS))
#define ROPES ((const float*)(ws + WS_TAB))
#define ROPEM ((const float*)(ws + WS_TAB) + 2048)
__global__ void __launch_bounds__(NTHR, 2) fwd_megakernel(Args args) {
    extern __shared__ __attribute__((aligned(16))) unsigned char lds_raw[];
    LAS unsigned char* lds = (LAS unsigned char*)lds_raw;
    cg::grid_group grid = cg::this_grid();
    const int wave_s = __builtin_amdgcn_readfirstlane((int)threadIdx.x >> 6);
    const int tid0 = threadIdx.x;
    const int G = gridDim.x, bid = blockIdx.x;
    ArgsP ap = (ArgsP)__builtin_amdgcn_kernarg_segment_ptr();

    for (int u = tid0; u < (LDS_BYTES - LDSCTL_OFF) / 4; u += NTHR) ((LAS unsigned*)(lds + LDSCTL_OFF))[u] = 0u;
    __syncthreads();
#if MK_XCD_BARRIER
    XcdBarrier bar; { PHASE_PTRS bar = xcd_barrier_post((unsigned*)(ws + WS_CTL) + 1024, (volatile LAS unsigned*)(lds + LDSCTL_OFF + 64)); }
#define GRID_BAR() xcd_barrier(bar)
#else
#define GRID_BAR() grid.sync()
#endif


    {
        PHASE_PTRS
        LAS float* vec = (LAS float*)lds; LAS float* red = (LAS float*)(lds + 20480);
        for (int i = tid; i < 5 * 1024; i += NTHR) { const int mi = i >> 10, k = i & 1023; const float c = (mi == 0) ? c_ctx[k] : cond_in[(mi - 1) * 1024 + k]; vec[i] = c / (1.0f + __expf(-c)); }
        __syncthreads();
        for (int it = bid; it < NL * 96; it += G) { const int l = it / 96, cb = it % 96;
            gemv5_item(w_ada + (size_t)l * 1024 * 6144, 6144, cb * 64, vec, red, MOD + (size_t)l * 5 * 6144, 6144, b_ada + (size_t)l * 6144, tid); }
        __syncthreads();
        if (bid == 0) {
            for (int i = tid; i < 1024; i += NTHR) { const int pos = i >> 4, f = i & 15; const float fr = exp2f(-(float)f * (1.0f / 16.0f) * 13.287712379549449f); const float a = (float)pos * fr;
                TAB[i] = cosf(a); TAB[1024 + i] = sinf(a); }
            for (int i = tid; i < 512; i += NTHR) { const int pos = i >> 3, f = i & 7; const float fr = exp2f(-(float)f * (1.0f / 8.0f) * 13.287712379549449f); const float a = (float)pos * fr;
                TAB[2048 + i] = cosf(a); TAB[2048 + 512 + i] = sinf(a); }
        }
        LAS float* scr = (LAS float*)(lds + 32768 + wave * 8704);
        constexpr int I_IN = 16 * 61, I_OUT = 16 * 32, I_1 = 16 * 128, I_2 = 64 * 32, I_UQ = 4 * 12, I_UKV = 2 * 16, I_PW = 4 * 2;
        constexpr int I_L = I_IN + I_OUT + I_1 + I_2 + I_UQ + I_UKV + I_PW;
        for (int it = gw; it < NL * I_L; it += NGW) {
            const int l = it / I_L; int r = it % I_L;
            if (r < I_IN) { transpose_item(w_in + (size_t)l * 1024 * 1952, 1024, 1952, WIN + (size_t)l * 2048 * 1024, 0, scr, r, lane); continue; } r -= I_IN;
            if (r < I_OUT) { transpose_item(w_out + (size_t)l * 1024 * 1024, 1024, 1024, WOUT + (size_t)l * 1024 * 1024, 0, scr, r, lane); continue; } r -= I_OUT;
            if (r < I_1) { transpose_item(mlp_w1 + (size_t)l * 1024 * 4096, 1024, 4096, W1B + (size_t)l * 4096 * 1024, 0, scr, r, lane); continue; } r -= I_1;
            if (r < I_2) { transpose_item(mlp_w2 + (size_t)l * 4096 * 1024, 4096, 1024, W2B + (size_t)l * 1024 * 4096, 0, scr, r, lane); continue; } r -= I_2;
            if (r < I_UQ) { transpose_item(mla_w_uq + (size_t)l * 256 * 384, 256, 384, WUQ + (size_t)l * 384 * 256, 0, scr, r, lane); continue; } r -= I_UQ;
            if (r < I_UKV) { transpose_item(mla_w_ukv + (size_t)l * 128 * 512, 128, 512, WUKV + (size_t)l * 512 * 128, 0, scr, r, lane); continue; } r -= I_UKV;
            { const int g = r >> 1; transpose_item(pool_w + (size_t)(l * 4 + g) * 4096, 64, 64, WPOOL + (size_t)(l * 4 + g) * 4096, 0, scr, r & 1, lane); }
        }
        for (int i = bid * NTHR + tid; i < NL * 96 * 128; i += G * NTHR) { const int l = i / (96 * 128), r = i % (96 * 128); *(v4u*)(WIN + (size_t)l * 2048 * 1024 + (size_t)1952 * 1024 + (size_t)r * 8) = (v4u){0u, 0u, 0u, 0u}; }
    }
    GRID_BAR();

    {
        PHASE_PTRS
        LAS float* vec = (LAS float*)lds; LAS float* red = (LAS float*)(lds + 20480);
        for (int it = bid; it < NL * 95; it += G) { const int l = it / 95, r = it % 95; const bool isD = r >= 31; const int cb = isD ? r - 31 : r;
            __syncthreads();
            for (int i = tid; i < 5 * 1024; i += NTHR) { const int mi = i >> 10, k = i & 1023; vec[i] = MOD[(size_t)(l * 5 + mi) * 6144 + (isD ? 3072 : 0) + k]; }
            __syncthreads();
            if (isD) gemv5_item(mlp_w1 + (size_t)l * 1024 * 4096, 4096, cb * 64, vec, red, BD + (size_t)l * 5 * 4096, 4096, nullptr, tid);
            else gemv5_item(w_in + (size_t)l * 1024 * 1952, 1952, cb * 64, vec, red, BA + (size_t)l * 5 * 2048, 2048, nullptr, tid);
        }
        for (int row = gw; row < MT; row += NGW) {
            const float* xr = (row < M_CTX) ? x_prompt + (size_t)row * 1024 : x_sample + (size_t)(row - M_CTX) * 1024; const int mi = (row < M_CTX) ? 0 : 1 + ((row - M_CTX) >> 11);
            const float* scp = MOD + (size_t)mi * 6144 + 1024; float ss = 0.f;
#pragma unroll
            for (int j = 0; j < 4; ++j) { const int c = 4 * lane + 256 * j; const f32x4 v = *(const f32x4*)(xr + c); ss += (v[0] * v[0] + v[1] * v[1]) + (v[2] * v[2] + v[3] * v[3]);
                const f32x4 g = *(const f32x4*)(norm1 + c), s = *(const f32x4*)(scp + c); const f32x4 o = v * g * (s + 1.0f);
                typedef unsigned u32x2v __attribute__((ext_vector_type(2))); u32x2v w; w.x = cvtpk(o[0], o[1]); w.y = cvtpk(o[2], o[3]); *(u32x2v*)(XS + (size_t)row * 1024 + c) = w; }
            ss = wave_sum(ss);
            if (lane < 16) PARTA[(size_t)row * 16 + lane] = (lane == 0) ? ss : 0.f;
        }
    }
    GRID_BAR();
    {
        PHASE_PTRS
        for (int it = gw; it < 256 * 10; it += NGW) {
            int lane = tid & 63; asm volatile("" : "+v"(lane));
            const int sub = it % 10, u = it / 10; const int l = u >> 6, b = (u >> 4) & 3, tile = u & 15;
            const size_t lb = (size_t)(l * 4 + b);
            const size_t crow0 = ((size_t)b * 4 + l) * 512;
            if (sub < 2) {
                const int h = 2 * sub + (lane >> 5);
                head_norm_task<true, false>(cache_na_k, 256, (int)crow0 + tile * 32, h * 64, nullptr, true, nullptr, 0, 0, CKNA + (lb * 4 + h) * 16 * 2048, tile, nullptr, lane);
            } else if (sub < 4) {
                for (int hh = 0; hh < 2; ++hh) { const int h = 2 * (sub - 2) + hh; vtrans_task<true>(cache_na_v, 256, (int)crow0 + tile * 32, h * 64, CVNA + (lb * 4 + h) * 16 * 2048, tile, nullptr, 0, lane); }
            } else if (sub == 4) {
                const int h = lane >> 5;
                head_norm_task<true, false>(cache_swa_k, 128, (int)crow0 + tile * 32, h * 64, nullptr, true, nullptr, 0, 0, CKS + (lb * 2 + h) * 16 * 2048, tile, nullptr, lane);
            } else if (sub == 5) {
                for (int h = 0; h < 2; ++h) vtrans_task<true>(cache_swa_v, 128, (int)crow0 + tile * 32, h * 64, CVS + (lb * 2 + h) * 16 * 2048, tile, nullptr, 0, lane);
            } else {
                const int h = sub - 6;
                mla_kv_task<true, false>(cache_ckv, 128, 0, cache_kpe, 32, 0, (int)crow0 + tile * 32, nullptr, WUKV + (size_t)l * 512 * 128, h, mla_k_norm + l * 96, nullptr, 0,
                                         CKM + (lb * 4 + h) * 16 * 3072, CVM + (lb * 4 + h) * 16 * 2048, tile, nullptr, nullptr, lane);
            }
        }
    }
    GRID_BAR();

    for (int l = 0; l < NL; ++l) {
        {
            PHASE_PTRS
            pg8::Gemm g{XS, WIN + (size_t)l * 2048 * 1024, MT, NPROJP, DM}; pg8::StaticOrder S; S.init(MT, NPROJP, G, bid);
            pg8::EpiScaleBias<0> E{PB, NPROJP, BA + (size_t)l * 5 * 2048, 2048, PARTA};
            pg8::gemm_phase<pg8::EpiScaleBias<0>, pg8::StaticOrder, true, true>(lds, g, S, E, tid);
        }
        GRID_BAR();
        {
            PHASE_PTRS
            for (int it = gw; it < NGT * 18; it += NGW) {
                int lane = tid & 63; asm volatile("" : "+v"(lane));
                const int gt = it / 18, sub = it % 18; const int row0 = gt * 32; const bool lat = gt >= GT_LAT0;
                const int tok = lane & 31; const TokInfo ti = tok_info(row0 + tok);
                const TokInfo t0i = tok_info(row0);
                const size_t crow = ((size_t)(t0i.b * 4 + l)) * 256 + t0i.t;
                if (sub < 7) {
                    const int hs = lane >> 5;
                    if (sub < 2) { const int h = 2 * sub + hs; head_norm_task<false, true>(PB, NPROJP, row0, C_NAQ + h * 64, na_q_norm + l * 64, false, nullptr, 0, 0, QNA + (size_t)h * NGT * 2048, gt, nullptr, lane); }
                    else if (sub < 4) { const int h = 2 * (sub - 2) + hs; head_norm_task<false, true>(PB, NPROJP, row0, C_NAK + h * 64, na_k_norm + l * 64, true, nullptr, 0, 0, KNA + (size_t)h * NGT * 2048, gt,
                                                                                           lat ? nullptr : out + O_NAK + (crow + tok) * 256 + h * 64, lane); }
                    else if (sub < 6) { const int h = 2 * (sub - 4) + hs; head_norm_task<false, true>(PB, NPROJP, row0, C_SQ + h * 64, swa_q_norm + l * 64, false, lat ? ROPES : nullptr, ti.t >> 6, ti.t & 63, QS + (size_t)h * NGT * 2048, gt, nullptr, lane); }
                    else { const int h = hs; head_norm_task<false, true>(PB, NPROJP, row0, C_SK + h * 64, swa_k_norm + l * 64, true, lat ? ROPES : nullptr, ti.t >> 6, ti.t & 63, KS + (size_t)h * NGT * 2048, gt,
                                                                         lat ? nullptr : out + O_SK + (crow + tok) * 128 + h * 64, lane); }
                } else if (sub < 9) {
                    for (int hh = 0; hh < 2; ++hh) { const int h = 2 * (sub - 7) + hh; vtrans_task<false>(PB, NPROJP, row0, C_NAV + h * 64, VNA + (size_t)h * NGT * 2048, gt, lat ? nullptr : out + O_NAV + crow * 256 + h * 64, 256, lane); }
                } else if (sub == 9) {
                    for (int h = 0; h < 2; ++h) vtrans_task<false>(PB, NPROJP, row0, C_SV + h * 64, VS + (size_t)h * NGT * 2048, gt, lat ? nullptr : out + O_SV + crow * 128 + h * 64, 128, lane);
                } else if (sub < 14) {
                    const int h = sub - 10;
                    mla_q_task(PB, row0, mla_q_a_norm + l * 256, WUQ + (size_t)l * 384 * 256, h, mla_q_norm + l * 96, ROPEM, QM + (size_t)h * NGT * 3072, gt, lane);
                } else {
                    const int h = sub - 14;
                    mla_kv_task<false, true>(PB, NPROJP, C_CKV, PB, NPROJP, C_KPE, row0, mla_kv_norm + l * 128, WUKV + (size_t)l * 512 * 128, h, mla_k_norm + l * 96, lat ? ROPEM : nullptr, t0i.t,
                                             KM + (size_t)h * NGT * 3072, VM + (size_t)h * NGT * 2048, gt, (!lat && h == 0) ? out + O_CKV + crow * 128 : nullptr, (!lat && h == 0) ? out + O_KPE + crow * 32 : nullptr, lane);
                }
            }
        }
        GRID_BAR();
        {
            PHASE_PTRS
            LAS float* rpb = (LAS float*)lds;
            __syncthreads();
            for (int i = tid; i < 4 * 465; i += NTHR) rpb[i] = na_rpb[(size_t)l * 4 * 465 + i] * LOG2E;
            __syncthreads();
            const float sc64 = 0.125f * LOG2E, sc96 = 0.10206207261596577f * LOG2E;
            if (wave < 4) {
                for (int it = bid * 4 + wave; it < 1024; it += G * 4) {
                    const int b = it >> 8, h = (it >> 6) & 3, qt = it & 63; const int gtq = GT_LAT0 + b * 64 + qt;
                    bf16x8 qf[6]; load_q<6>(qf, QM + (size_t)h * NGT * 3072, gtq, lane);
                    float m = NEGBIG, lsum = 0.f; f32x16 o0 = {0.f, 0.f, 0.f, 0.f, 0.f, 0.f, 0.f, 0.f, 0.f, 0.f, 0.f, 0.f, 0.f, 0.f, 0.f, 0.f}, o1 = o0;
                    attn_range<6, 0>(m, lsum, o0, o1, qf, KM + (size_t)h * NGT * 3072, VM + (size_t)h * NGT * 2048, GT_LAT0 + b * 64, GT_LAT0 + b * 64 + 64, lane, sc96, 0, 0, rpb);
                    const size_t cb = ((size_t)(l * 4 + b) * 4 + h) * 16;
                    attn_range<6, 0>(m, lsum, o0, o1, qf, CKM + cb * 3072, CVM + cb * 2048, 0, 16, lane, sc96, 0, 0, rpb);
                    attn_store(m, lsum, o0, o1, false, 0.f, MIX + (size_t)(gtq * 32 + (lane & 31)) * 1024 + 512 + h * 64, lane);
                }
            } else {
                for (int it = bid * 4 + (wave - 4); it < 5120; it += G * 4) {
                    int lane = tid & 63; asm volatile("" : "+v"(lane));
                    if (it < 1024) {
                        const int b = it >> 8, h = (it >> 6) & 3, qt = it & 63; const int gt0 = GT_LAT0 + b * 64, gtq = gt0 + qt; const int kvh = h >> 1;
                        bf16x8 qf[4]; load_q<4>(qf, QS + (size_t)h * NGT * 2048, gtq, lane);
                        float m = NEGBIG, lsum = 0.f; f32x16 o0 = {0.f, 0.f, 0.f, 0.f, 0.f, 0.f, 0.f, 0.f, 0.f, 0.f, 0.f, 0.f, 0.f, 0.f, 0.f, 0.f}, o1 = o0;
                        const int ta = qt - 4 < 0 ? 0 : qt - 4, tb = qt + 5 > 64 ? 64 : qt + 5;
                        attn_range<4, 2>(m, lsum, o0, o1, qf, KS + (size_t)kvh * NGT * 2048, VS + (size_t)kvh * NGT * 2048, gt0 + ta, gt0 + tb, lane, sc64, gt0, qt * 32 + (lane & 31), rpb);
                        const size_t cb = ((size_t)(l * 4 + b) * 2 + kvh) * 16;
                        attn_range<4, 0>(m, lsum, o0, o1, qf, CKS + cb * 2048, CVS + cb * 2048, 0, 16, lane, sc64, 0, 0, rpb);
                        attn_store(m, lsum, o0, o1, true, swa_sink[l * 4 + h], MIX + (size_t)(gtq * 32 + (lane & 31)) * 1024 + 768 + h * 64, lane);
                    } else if (it < 2048) {
                        const int j = it - 1024; const int b = j >> 8, h = (j >> 6) & 3, qr = (j >> 1) & 31, hc = j & 1; const int gt0 = GT_LAT0 + b * 64, gtq = gt0 + qr * 2 + hc;
                        bf16x8 qf[4]; load_q<4>(qf, QNA + (size_t)h * NGT * 2048, gtq, lane);
                        float m = NEGBIG, lsum = 0.f; f32x16 o0 = {0.f, 0.f, 0.f, 0.f, 0.f, 0.f, 0.f, 0.f, 0.f, 0.f, 0.f, 0.f, 0.f, 0.f, 0.f, 0.f}, o1 = o0;
                        int kr0 = qr - 4; kr0 = kr0 < 0 ? 0 : (kr0 > 24 ? 24 : kr0);
                        attn_range<4, 1>(m, lsum, o0, o1, qf, KNA + (size_t)h * NGT * 2048, VNA + (size_t)h * NGT * 2048, gt0 + kr0 * 2, gt0 + kr0 * 2 + 16, lane, sc64, gt0, qr * 64 + hc * 32 + (lane & 31), rpb + h * 465);
                        const size_t cb = ((size_t)(l * 4 + b) * 4 + h) * 16;
                        attn_range<4, 0>(m, lsum, o0, o1, qf, CKNA + cb * 2048, CVNA + cb * 2048, 0, 16, lane, sc64, 0, 0, rpb);
                        attn_store(m, lsum, o0, o1, false, 0.f, MIX + (size_t)(gtq * 32 + (lane & 31)) * 1024 + 0 + h * 64, lane);
                    } else if (it < 3584) {
                        const int j = it - 2048; const int kind = j >> 9, b = (j >> 5) & 15, h = (j >> 3) & 3, qt = j & 7; const int gt0 = b * 8, gtq = gt0 + qt;
                        float m = NEGBIG, lsum = 0.f; f32x16 o0 = {0.f, 0.f, 0.f, 0.f, 0.f, 0.f, 0.f, 0.f, 0.f, 0.f, 0.f, 0.f, 0.f, 0.f, 0.f, 0.f}, o1 = o0;
                        if (kind == 1) {
                            bf16x8 qf[6]; load_q<6>(qf, QM + (size_t)h * NGT * 3072, gtq, lane);
                            attn_range<6, 0>(m, lsum, o0, o1, qf, KM + (size_t)h * NGT * 3072, VM + (size_t)h * NGT * 2048, gt0, gt0 + 8, lane, sc96, 0, 0, rpb);
                            attn_store(m, lsum, o0, o1, false, 0.f, MIX + (size_t)(gtq * 32 + (lane & 31)) * 1024 + 512 + h * 64, lane);
                        } else if (kind == 0) {
                            bf16x8 qf[4]; load_q<4>(qf, QNA + (size_t)h * NGT * 2048, gtq, lane);
                            attn_range<4, 0>(m, lsum, o0, o1, qf, KNA + (size_t)h * NGT * 2048, VNA + (size_t)h * NGT * 2048, gt0, gt0 + 8, lane, sc64, 0, 0, rpb);
                            attn_store(m, lsum, o0, o1, false, 0.f, MIX + (size_t)(gtq * 32 + (lane & 31)) * 1024 + 0 + h * 64, lane);
                        } else {
                            const int kvh = h >> 1;
                            bf16x8 qf[4]; load_q<4>(qf, QS + (size_t)h * NGT * 2048, gtq, lane);
                            attn_range<4, 0>(m, lsum, o0, o1, qf, KS + (size_t)kvh * NGT * 2048, VS + (size_t)kvh * NGT * 2048, gt0, gt0 + 8, lane, sc64, 0, 0, rpb);
                            attn_store(m, lsum, o0, o1, true, swa_sink[l * 4 + h], MIX + (size_t)(gtq * 32 + (lane & 31)) * 1024 + 768 + h * 64, lane);
                        }
                    } else {
                        const int j = it - 3584; const int gt = j >> 2, g = j & 3; const int tok = lane & 31, kh = lane >> 5; const int row = gt * 32 + tok; const TokInfo ti = tok_info(row);
                        const int n = ti.lat ? 2048 : 256; const int w = 2 << g; const int rowbase = row - ti.t;
                        float sum[4][8], own[4][8];
#pragma unroll
                        for (int kc = 0; kc < 4; ++kc) { load8<false>(PB, (size_t)row * NPROJP + C_POOL + g * 64 + 16 * kc + 8 * kh, own[kc]);
#pragma unroll
                            for (int e = 0; e < 8; ++e) sum[kc][e] = 0.f; }
                        int cnt = 0;
                        for (int jj = 0; jj < w; ++jj) { const int s = ti.t - (w >> 1) + jj; const bool ok = (s >= 0) && (s < n); const int sr = ok ? s : ti.t; cnt += ok ? 1 : 0;
#pragma unroll
                            for (int kc = 0; kc < 4; ++kc) { float f[8]; load8<false>(PB, (size_t)(rowbase + sr) * NPROJP + C_POOL + g * 64 + 16 * kc + 8 * kh, f);
#pragma unroll
                                for (int e = 0; e < 8; ++e) sum[kc][e] += ok ? f[e] : 0.f; } }
                        const float inv = 1.0f / (float)cnt;
                        bf16x8 bfr[4];
#pragma unroll
                        for (int kc = 0; kc < 4; ++kc) { float pz[8];
#pragma unroll
                            for (int e = 0; e < 8; ++e) pz[e] = sum[kc][e] * inv - own[kc][e];
                            bfr[kc] = PACK8ARR(pz, 0); }
                        const bf16* wp = WPOOL + (size_t)(l * 4 + g) * 4096;
#pragma unroll
                        for (int ft = 0; ft < 2; ++ft) {
                            f32x16 acc = {0.f, 0.f, 0.f, 0.f, 0.f, 0.f, 0.f, 0.f, 0.f, 0.f, 0.f, 0.f, 0.f, 0.f, 0.f, 0.f};
                            const bf16* wr = wp + (size_t)(32 * ft + swz(tok)) * 64 + 8 * kh;
#pragma unroll
                            for (int kc = 0; kc < 4; ++kc) acc = mfma32(*(const bf16x8*)(wr + 16 * kc), bfr[kc], acc);
#pragma unroll
                            for (int s = 0; s < 2; ++s) { const float* ps = pool_scale + l * 256 + g * 64 + 32 * ft + 16 * s + 8 * kh; const f32x4 s0 = *(const f32x4*)ps, s1 = *(const f32x4*)(ps + 4);
                                *(bf16x8*)(MIX + (size_t)row * 1024 + 256 + g * 64 + 32 * ft + 16 * s + 8 * kh) =
                                    pack8(acc[8 * s] * s0[0], acc[8 * s + 1] * s0[1], acc[8 * s + 2] * s0[2], acc[8 * s + 3] * s0[3], acc[8 * s + 4] * s1[0], acc[8 * s + 5] * s1[1], acc[8 * s + 6] * s1[2], acc[8 * s + 7] * s1[3]); }
                        }
                    }
                }
            }
        }
        GRID_BAR();
        {
            PHASE_PTRS
            pg8::Gemm g{MIX, WOUT + (size_t)l * 1024 * 1024, MT, DM, DM}; pg8::StaticOrder S; S.init(MT, DM, G, bid);
            pg8::EpiResid E{l == 0 ? x_prompt : XB, l == 0 ? x_sample : XB + (size_t)M_CTX * 1024, XB, XS, MOD + (size_t)l * 5 * 6144 + 2048, norm2 + l * 1024, MOD + (size_t)l * 5 * 6144 + 4096, PARTD};
            pg8::gemm_phase<pg8::EpiResid, pg8::StaticOrder, true, true>(lds, g, S, E, tid);
        }
        GRID_BAR();
        {
            PHASE_PTRS
            pg8::Gemm g{XS, W1B + (size_t)l * 4096 * 1024, MT, DFF, DM}; pg8::StaticOrder S; S.init(MT, DFF, G, bid);
            pg8::EpiScaleBias<1> E{ZB, DFF, BD + (size_t)l * 5 * 4096, 4096, PARTD};
            pg8::gemm_phase<pg8::EpiScaleBias<1>, pg8::StaticOrder, true, true>(lds, g, S, E, tid);
        }
        GRID_BAR();
        {
            PHASE_PTRS
            const bool last = (l == NL - 1);
            pg8::Gemm g{ZB, W2B + (size_t)l * 1024 * 4096, MT, DM, DFF}; pg8::StaticOrder S; S.init(MT, DM, G, bid);
            pg8::EpiResid E{XB, XB + (size_t)M_CTX * 1024, last ? out : XB, last ? nullptr : XS, MOD + (size_t)l * 5 * 6144 + 5120, norm1 + (last ? 0 : (l + 1) * 1024), MOD + (size_t)(last ? 0 : (l + 1)) * 5 * 6144 + 1024, PARTA};
            pg8::gemm_phase<pg8::EpiResid, pg8::StaticOrder, true, true>(lds, g, S, E, tid);
        }
        if (l + 1 < NL) GRID_BAR();
    }
}
}

extern "C" void kernel_launch(void* const* d_in, const int* in_sizes, int n_in, void* d_out, int out_size, void* d_ws, size_t ws_size, hipStream_t stream) {
    static int grid = 0;
    if (grid == 0) {
        if (n_in != 32 || ws_size < mk::WS_END) { fprintf(stderr, "kernel_launch: unexpected n_in %d / ws_size %zu\n", n_in, ws_size); grid = -1; return; }
        int dev = 0, cus = 0, per_cu = 0;
        hipGetDevice(&dev); hipDeviceGetAttribute(&cus, hipDeviceAttributeMultiprocessorCount, dev);
        if (hipFuncSetAttribute((const void*)mk::fwd_megakernel, hipFuncAttributeMaxDynamicSharedMemorySize, mk::LDS_BYTES) != hipSuccess) { fprintf(stderr, "kernel_launch: hipFuncSetAttribute failed\n"); grid = -1; return; }
        if (hipOccupancyMaxActiveBlocksPerMultiprocessor(&per_cu, (const void*)mk::fwd_megakernel, mk::NTHR, mk::LDS_BYTES) != hipSuccess || per_cu < 1) { fprintf(stderr, "kernel_launch: occupancy query failed (%d)\n", per_cu); (void)hipGetLastError(); per_cu = 1; }
        grid = cus * per_cu;
        fprintf(stderr, "kernel_launch: grid %d (cus %d x %d)\n", grid, cus, per_cu);
    }
    if (grid < 0) return;
    (void)hipMemsetAsync((char*)d_ws + mk::WS_CTL, 0, mk::CTL_ZERO_BYTES, stream);
    mk::Args a{};
    for (int i = 0; i < 32; ++i) a.in[i] = (const float*)d_in[i];
    a.out = (float*)d_out; a.ws = (unsigned char*)d_ws;
    void* params[] = {&a};
    hipError_t e = hipLaunchCooperativeKernel((const void*)mk::fwd_megakernel, dim3(grid), dim3(mk::NTHR), params, mk::LDS_BYTES, stream);
    if (e != hipSuccess) fprintf(stderr, "kernel_launch: cooperative launch failed: %s (grid %d)\n", hipGetErrorString(e), grid);
}
```

```cpp
#include <hip/hip_runtime.h>
#include <hip/hip_cooperative_groups.h>
#include <cstdio>
#include <cstdint>
namespace cg = cooperative_groups;
#ifndef MK_XCD_BARRIER
#define MK_XCD_BARRIER 0
#endif
namespace pg8 {
#define PG8_LAS __attribute__((address_space(3)))
typedef unsigned short bf16_t;
typedef short bf16x8 __attribute__((ext_vector_type(8)));
typedef float f32x4 __attribute__((ext_vector_type(4)));
typedef unsigned u32x4 __attribute__((ext_vector_type(4)));
constexpr int BM = 256, BK = 64, HALF = 128, HTB = HALF * BK * 2  , STAGE_BYTES = 8 * HTB, NXCD = 8, WGM = 3;

__host__ __device__ __forceinline__ int lds_byte(int r, int c) { const int st = (r >> 4) * 2 + (c >> 5), rr = r & 15, cc = c & 31, ob = rr * 64 + cc * 2; return st * 1024 + (ob ^ (((ob >> 9) & 1) << 5)); }
__host__ __device__ __forceinline__ void stage_rc(int b, int& R, int& C) { const int st = b / 1024, sb = b % 1024, swz = sb ^ (((sb >> 9) & 1) << 5); R = (st >> 1) * 16 + swz / 64; C = (st & 1) * 32 + (swz % 64) / 2; }
__host__ __device__ __forceinline__ int perm32(int rho) { const int n = rho >> 4, i = rho & 15; return 8 * (i >> 2) + 4 * n + (i & 3); }

struct Unit { int pm, pn; };
struct Gemm { const bf16_t* A; const bf16_t* Bt; int M, N, K; };

struct StaticOrder {
    int nM, nN, nwg, G, c;
    __host__ __device__ void init(int M, int N, int G_, int c_, int bm = BM) { nM = M / bm; nN = N / BM; nwg = nM * nN; G = G_; c = c_; }
    __host__ __device__ bool next(int i, Unit& u) const {
        const long L = (long)i * G + c; if (L >= nwg) return false;
        int wgid = (int)L; { const int q = nwg / NXCD, r = nwg % NXCD, xcd = wgid % NXCD, off = wgid / NXCD; wgid = (xcd < r ? xcd * (q + 1) : r * (q + 1) + (xcd - r) * q) + off; }
        const int nig = WGM * nN, gid = wgid / nig, fm = gid * WGM, gsz = (nM - fm) < WGM ? (nM - fm) : WGM;
        u.pm = fm + ((wgid % nig) % gsz); u.pn = (wgid % nig) / gsz; return true;
    }
    __device__ __forceinline__ void a_ready(const Unit&) const {}
    __device__ __forceinline__ void done(const Unit&) const {}
};

__device__ __forceinline__ unsigned cvt_pk_bf16(float lo, float hi) { unsigned r; asm volatile("v_cvt_pk_bf16_f32 %0, %1, %2" : "=v"(r) : "v"(lo), "v"(hi)); return r; }
__device__ __forceinline__ int mod_index_row(int row) { return row < 4096 ? 0 : 1 + ((row - 4096) >> 11); }

template <int MT> __device__ __forceinline__ void rows_rstd(const float* part, int rowb, int fr, int fq, float (&rs)[2][MT]) {
    constexpr int HR = 32 * MT;
    f32x4 pv[2][MT];
#pragma unroll
    for (int ai = 0; ai < 2; ++ai)
#pragma unroll
        for (int m = 0; m < MT; ++m) pv[ai][m] = *(const f32x4*)(part + (size_t)(rowb + ai * HR + m * 16 + fr) * 16 + 4 * fq);
#pragma unroll
    for (int ai = 0; ai < 2; ++ai)
#pragma unroll
        for (int m = 0; m < MT; ++m) { float s = (pv[ai][m][0] + pv[ai][m][1]) + (pv[ai][m][2] + pv[ai][m][3]); s += __shfl_xor(s, 16); s += __shfl_xor(s, 32);
            rs[ai][m] = 1.0f / sqrtf(s * (1.0f / 1024.0f) + 1e-6f); }
}

template <int ACT, bool BLK = false> struct EpiScaleBias {
    static constexpr bool PERM = true, AFTER_DRAIN = false;
    bf16_t* O; int ldc; const float* bias; int ldb; const float* part;
    template <int MT>
    __device__ __forceinline__ void operator()(const f32x4 (&acc)[2][2][MT][2], const Unit& u, int wr, int wc, int fr, int fq) const {
        constexpr int HR = 32 * MT;
        asm volatile("" : "+v"(fr), "+v"(fq));
        const int rowb = u.pm * (2 * HR) + wr * (HR / 2); const int col0 = u.pn * BM + wc * 32 + 8 * fq;
        const int mi0 = mod_index_row(rowb), mi1 = mod_index_row(rowb + HR + (MT - 1) * 16);
        f32x4 bb[2][2];
#pragma unroll
        for (int bj = 0; bj < 2; ++bj) { const float* bp = bias + (size_t)mi0 * ldb + col0 + bj * HALF; bb[bj][0] = *(const f32x4*)bp; bb[bj][1] = *(const f32x4*)(bp + 4); }
        float rs[2][MT]; rows_rstd<MT>(part, rowb, fr, fq, rs);
#pragma unroll
        for (int ai = 0; ai < 2; ++ai)
#pragma unroll
            for (int m = 0; m < MT; ++m) { const int grow = rowb + ai * HR + m * 16; const int row = grow + fr; const float r1 = rs[ai][m];
                f32x4 c[2][2] = {{bb[0][0], bb[0][1]}, {bb[1][0], bb[1][1]}};
                if (mi0 != mi1) { const int mg = mod_index_row(grow); if (mg != mi0) {
#pragma unroll
                    for (int bj = 0; bj < 2; ++bj) { const float* bp = bias + (size_t)mg * ldb + col0 + bj * HALF; c[bj][0] = *(const f32x4*)bp; c[bj][1] = *(const f32x4*)(bp + 4); } } }
                bf16_t* rowp = BLK ? O + (((size_t)((row >> 5) * 256 + (col0 >> 3))) << 8) + ((row & 31) << 3) : O + (size_t)row * ldc + col0;
#pragma unroll
                for (int bj = 0; bj < 2; ++bj) { f32x4 v0 = acc[ai][bj][m][0] * r1 + c[bj][0], v1 = acc[ai][bj][m][1] * r1 + c[bj][1];
                    if (ACT == 1) {
#pragma unroll
                        for (int e = 0; e < 4; ++e) { const float a = fmaxf(v0[e], 0.f), b = fmaxf(v1[e], 0.f); v0[e] = a * a; v1[e] = b * b; } }
                    u32x4 w; w.x = cvt_pk_bf16(v0[0], v0[1]); w.y = cvt_pk_bf16(v0[2], v0[3]); w.z = cvt_pk_bf16(v1[0], v1[1]); w.w = cvt_pk_bf16(v1[2], v1[3]);
                    *(u32x4*)(rowp + (BLK ? bj * (HALF / 8) * 256 : bj * HALF)) = w; } }
    }
};

struct EpiResid {
    static constexpr bool PERM = false, AFTER_DRAIN = false;
    const float* xinA; const float* xinB;
    float* xout; bf16_t* xs; const float* gate; const float* normg; const float* sc; float* part;
    template <int MT>
    __device__ __forceinline__ void operator()(const f32x4 (&acc)[2][2][MT][2], const Unit& u, int wr, int wc, int fr, int fq) const {
        typedef unsigned u32x2v __attribute__((ext_vector_type(2)));
        constexpr int HR = 32 * MT;
        asm volatile("" : "+v"(fr), "+v"(fq));
        const int rowb = u.pm * (2 * HR) + wr * (HR / 2); const int col0 = u.pn * BM + wc * 32 + 4 * fq;
        const int mi0 = mod_index_row(rowb), mi1 = mod_index_row(rowb + HR + (MT - 1) * 16);
        f32x4 gv0[2][2], sv0[2][2];
#pragma unroll
        for (int bj = 0; bj < 2; ++bj)
#pragma unroll
            for (int n = 0; n < 2; ++n) { const int c = col0 + bj * HALF + n * 16; gv0[bj][n] = *(const f32x4*)(gate + (size_t)mi0 * 6144 + c);
                sv0[bj][n] = xs ? *(const f32x4*)(normg + c) * (*(const f32x4*)(sc + (size_t)mi0 * 6144 + c) + 1.0f) : (f32x4){0.f, 0.f, 0.f, 0.f}; }
        f32x4 xc[2][2], xn_[2][2];
        { const int row = rowb + fr; const float* xr = (row < 4096) ? xinA + (size_t)row * 1024 : xinB + (size_t)(row - 4096) * 1024;
#pragma unroll
          for (int bj = 0; bj < 2; ++bj)
#pragma unroll
              for (int n = 0; n < 2; ++n) xc[bj][n] = *(const f32x4*)(xr + col0 + bj * HALF + n * 16); }
#pragma unroll
        for (int ai = 0; ai < 2; ++ai)
#pragma unroll
            for (int m = 0; m < MT; ++m) { const int grow = rowb + ai * HR + m * 16; const int row = grow + fr;
                if (!(ai == 1 && m == MT - 1)) { const int nrow = rowb + (m == MT - 1 ? HR : ai * HR + (m + 1) * 16) + fr;
                    const float* xr = (nrow < 4096) ? xinA + (size_t)nrow * 1024 : xinB + (size_t)(nrow - 4096) * 1024;
#pragma unroll
                    for (int bj = 0; bj < 2; ++bj)
#pragma unroll
                        for (int n = 0; n < 2; ++n) xn_[bj][n] = *(const f32x4*)(xr + col0 + bj * HALF + n * 16); }
                f32x4 gv[2][2] = {{gv0[0][0], gv0[0][1]}, {gv0[1][0], gv0[1][1]}}, sv[2][2] = {{sv0[0][0], sv0[0][1]}, {sv0[1][0], sv0[1][1]}};
                if (mi0 != mi1) { const int mg = mod_index_row(grow); if (mg != mi0) {
#pragma unroll
                    for (int bj = 0; bj < 2; ++bj)
#pragma unroll
                        for (int n = 0; n < 2; ++n) { const int c = col0 + bj * HALF + n * 16; gv[bj][n] = *(const f32x4*)(gate + (size_t)mg * 6144 + c);
                            if (xs) sv[bj][n] = *(const f32x4*)(normg + c) * (*(const f32x4*)(sc + (size_t)mg * 6144 + c) + 1.0f); } } }
                float ss = 0.f;
#pragma unroll
                for (int bj = 0; bj < 2; ++bj)
#pragma unroll
                    for (int n = 0; n < 2; ++n) { const int c = col0 + bj * HALF + n * 16; const f32x4 xn = xc[bj][n] + gv[bj][n] * acc[ai][bj][m][n];
                        *(f32x4*)(xout + (size_t)row * 1024 + c) = xn; ss += (xn[0] * xn[0] + xn[1] * xn[1]) + (xn[2] * xn[2] + xn[3] * xn[3]);
                        if (xs) { const f32x4 o = xn * sv[bj][n]; u32x2v w; w.x = cvt_pk_bf16(o[0], o[1]); w.y = cvt_pk_bf16(o[2], o[3]); *(u32x2v*)(xs + (size_t)row * 1024 + c) = w; } }
                ss += __shfl_xor(ss, 16); ss += __shfl_xor(ss, 32);
                if (fq == 0) part[(size_t)row * 16 + u.pn * 4 + wc] = ss;
#pragma unroll
                for (int bj = 0; bj < 2; ++bj)
#pragma unroll
                    for (int n = 0; n < 2; ++n) xc[bj][n] = xn_[bj][n]; }
    }
};

template <class Epi, class Sched, bool ALIGN_EPI = false, bool SP2 = false, int MT = 4>
__device__ __forceinline__ void gemm_phase(PG8_LAS unsigned char* lds, const Gemm g, const Sched& S, const Epi& E, int tid_in) {
    int tid = tid_in; asm volatile("" : "+v"(tid));
    const int wid = __builtin_amdgcn_readfirstlane(tid >> 6), lane = tid & 63, wr = wid >> 2, wc = wid & 3, fr = lane & 15, fq = lane >> 4;
    const int K = g.K, nt = K / BK;
    unsigned voffA[2], voffB[2];
#pragma unroll
    for (int i = 0; i < 2; ++i) { int R, C; stage_rc(tid * 16 + i * 8192, R, C); const int Rb = Epi::PERM ? ((R & ~31) + perm32(R & 31)) : R;
        voffA[i] = (unsigned)(R * K + C) * 2u; voffB[i] = (unsigned)(Rb * K + C) * 2u; }
    const size_t kstep = (size_t)(BK * 2);
    static_assert(MT == 4 || (MT == 3 && SP2), "the 192-row tile is only wired into the two-super-phase loop");
    constexpr int HR = 32 * MT;
    const size_t hstepA = (size_t)HR * K * 2, hstepB = (size_t)HALF * K * 2;
    const size_t tstepA = 2 * hstepA, tstepB = 2 * hstepB;
    const unsigned ldsw = (unsigned)wid * 1024u;
    const int aoff = lds_byte(wr * (HR / 2) + fr, fq * 8), boff = lds_byte(wc * 32 + fr, fq * 8);
#define PG8_SA(b, h) (((b) * 2 + (h)) * HTB)
#define PG8_SB(b, h) ((4 + (b) * 2 + (h)) * HTB)
#define PG8_STAGE(bufoff, gbase, voff) do { _Pragma("unroll") for (int _i = 0; _i < 2; ++_i) \
        __builtin_amdgcn_global_load_lds((const unsigned*)((const char*)(gbase) + (voff)[_i]), (PG8_LAS unsigned*)(lds + (bufoff) + ldsw + _i * 8192), 16, 0, 0); } while (0)
#define PG8_STAGEA(bufoff, gbase, voff) do { __builtin_amdgcn_global_load_lds((const unsigned*)((const char*)(gbase) + (voff)[0]), (PG8_LAS unsigned*)(lds + (bufoff) + ldsw), 16, 0, 0); \
        if (MT == 4 || wr == 0) __builtin_amdgcn_global_load_lds((const unsigned*)((const char*)(gbase) + (voff)[1]), (PG8_LAS unsigned*)(lds + (bufoff) + ldsw + 8192), 16, 0, 0); } while (0)
#define PG8_WAIT_VA(nfull, nred) do { if (MT == 4 || wr == 0) asm volatile("s_waitcnt vmcnt(" #nfull ")" ::: "memory"); else asm volatile("s_waitcnt vmcnt(" #nred ")" ::: "memory"); } while (0)
#define PG8_LDA(dst, b, h) do { _Pragma("unroll") for (int m = 0; m < MT; ++m) _Pragma("unroll") for (int k = 0; k < 2; ++k) dst[m][k] = *(const PG8_LAS bf16x8*)(lds + PG8_SA(b, h) + aoff + m * 2048 + k * 1024); } while (0)
#define PG8_LDB(dst, b, h) do { _Pragma("unroll") for (int n = 0; n < 2; ++n) _Pragma("unroll") for (int k = 0; k < 2; ++k) dst[n][k] = *(const PG8_LAS bf16x8*)(lds + PG8_SB(b, h) + boff + n * 2048 + k * 1024); } while (0)
#define PG8_MMA(ai, bj, At, Bt) do { __builtin_amdgcn_s_setprio(1); _Pragma("unroll") for (int m = 0; m < MT; ++m) _Pragma("unroll") for (int n = 0; n < 2; ++n) _Pragma("unroll") for (int k = 0; k < 2; ++k) \
        acc[ai][bj][m][n] = __builtin_amdgcn_mfma_f32_16x16x32_bf16(Bt[n][k], At[m][k], acc[ai][bj][m][n], 0, 0, 0); __builtin_amdgcn_s_setprio(0); } while (0)
#define PG8_WAIT_V(n) asm volatile("s_waitcnt vmcnt(" #n ")" ::: "memory")
#define PG8_WAIT_L(n) asm volatile("s_waitcnt lgkmcnt(" #n ")" ::: "memory")
#define PG8_BAR __builtin_amdgcn_s_barrier()
#define PG8_SCHED __builtin_amdgcn_sched_barrier(0)
    Unit cur, nxt; int ui = 0;
    if (!S.next(0, cur)) return;
    f32x4 acc[2][2][MT][2];
#pragma unroll
    for (int a = 0; a < 2; ++a)
#pragma unroll
        for (int b = 0; b < 2; ++b)
#pragma unroll
            for (int m = 0; m < MT; ++m)
#pragma unroll
                for (int n = 0; n < 2; ++n) acc[a][b][m][n] = (f32x4){0.f, 0.f, 0.f, 0.f};
    bf16x8 At[MT][2], B0[2][2], B1[2][2];
    const char* cA = (const char*)g.A + (size_t)cur.pm * tstepA; const char* cB = (const char*)g.Bt + (size_t)cur.pn * tstepB;
    S.a_ready(cur);
    if constexpr (SP2) {
        PG8_STAGE(PG8_SB(0, 0), cB, voffB); PG8_STAGE(PG8_SB(0, 1), cB + hstepB, voffB); PG8_STAGEA(PG8_SA(0, 0), cA, voffA); PG8_STAGEA(PG8_SA(0, 1), cA + hstepA, voffA);
        if (wr == 1) PG8_BAR;
        PG8_WAIT_VA(2, 1); PG8_BAR;
        PG8_STAGE(PG8_SB(1, 0), cB + kstep, voffB); PG8_STAGEA(PG8_SA(1, 0), cA + kstep, voffA); PG8_STAGE(PG8_SB(1, 1), cB + hstepB + kstep, voffB);
        PG8_WAIT_VA(6, 5); PG8_BAR;
    } else {
        PG8_STAGE(PG8_SB(0, 0), cB, voffB); PG8_STAGEA(PG8_SA(0, 0), cA, voffA); PG8_STAGE(PG8_SB(0, 1), cB + hstepB, voffB); PG8_STAGEA(PG8_SA(0, 1), cA + hstepA, voffA);
        if (wr == 1) PG8_BAR;
        PG8_WAIT_V(4); PG8_BAR;
        PG8_STAGE(PG8_SB(1, 0), cB + kstep, voffB); PG8_STAGEA(PG8_SA(1, 0), cA + kstep, voffA); PG8_STAGE(PG8_SB(1, 1), cB + hstepB + kstep, voffB);
        PG8_WAIT_V(6); PG8_BAR;
    }
    for (;;) {
        const bool has_next = S.next(ui + 1, nxt);
        const char* nA = has_next ? (const char*)g.A + (size_t)nxt.pm * tstepA : cA; const char* nB = has_next ? (const char*)g.Bt + (size_t)nxt.pn * tstepB : cB;
        for (int t = 0; t < nt; t += 2) {
            const bool last = (t == nt - 2);
            const char* a1 = cA + (size_t)(t + 1) * kstep;
            const char* a2 = last ? nA : cA + (size_t)(t + 2) * kstep; const char* b2 = last ? nB : cB + (size_t)(t + 2) * kstep;
            const char* a3 = a2 + kstep; const char* b3 = b2 + kstep;
            if (last && has_next) S.a_ready(nxt);
            if constexpr (SP2) {
            PG8_LDB(B0, 0, 0); PG8_LDB(B1, 0, 1); PG8_SCHED; PG8_LDA(At, 0, 0); PG8_STAGEA(PG8_SA(1, 1), a1 + hstepA, voffA);
            PG8_WAIT_VA(8, 6); PG8_WAIT_L(0); PG8_BAR; PG8_MMA(0, 0, At, B0); PG8_MMA(0, 1, At, B1); PG8_BAR; PG8_SCHED;
            PG8_LDA(At, 0, 1); PG8_STAGE(PG8_SB(0, 0), b2, voffB); PG8_STAGE(PG8_SB(0, 1), b2 + hstepB, voffB); PG8_STAGEA(PG8_SA(0, 0), a2, voffA);
            PG8_WAIT_VA(8, 6); PG8_WAIT_L(0); PG8_BAR; PG8_MMA(1, 0, At, B0); PG8_MMA(1, 1, At, B1); PG8_BAR; PG8_SCHED;
            PG8_LDB(B0, 1, 0); PG8_LDB(B1, 1, 1); PG8_SCHED; PG8_LDA(At, 1, 0); PG8_STAGEA(PG8_SA(0, 1), a2 + hstepA, voffA);
            PG8_WAIT_VA(8, 6); PG8_WAIT_L(0); PG8_BAR; PG8_MMA(0, 0, At, B0); PG8_MMA(0, 1, At, B1); PG8_BAR; PG8_SCHED;
            PG8_LDA(At, 1, 1); PG8_STAGE(PG8_SB(1, 0), b3, voffB); PG8_STAGE(PG8_SB(1, 1), b3 + hstepB, voffB); PG8_STAGEA(PG8_SA(1, 0), a3, voffA);
            PG8_WAIT_VA(8, 6); PG8_WAIT_L(0); PG8_BAR; PG8_MMA(1, 0, At, B0); PG8_MMA(1, 1, At, B1); PG8_BAR; PG8_SCHED;
            } else {
            PG8_LDB(B0, 0, 0); PG8_SCHED; PG8_LDA(At, 0, 0); PG8_STAGEA(PG8_SA(1, 1), a1 + hstepA, voffA);
            PG8_WAIT_L(8); PG8_BAR; PG8_WAIT_L(0); PG8_MMA(0, 0, At, B0); PG8_BAR; PG8_SCHED;
            PG8_LDB(B1, 0, 1); PG8_STAGE(PG8_SB(0, 0), b2, voffB);
            PG8_BAR; PG8_WAIT_L(0); PG8_MMA(0, 1, At, B1); PG8_BAR;
            PG8_LDA(At, 0, 1); PG8_STAGEA(PG8_SA(0, 0), a2, voffA);
            PG8_BAR; PG8_WAIT_L(0); PG8_MMA(1, 0, At, B0); PG8_BAR; PG8_SCHED;
            PG8_STAGE(PG8_SB(0, 1), b2 + hstepB, voffB);
            PG8_WAIT_V(6); PG8_BAR; PG8_MMA(1, 1, At, B1); PG8_BAR;
            PG8_LDB(B0, 1, 0); PG8_SCHED; PG8_LDA(At, 1, 0); PG8_STAGEA(PG8_SA(0, 1), a2 + hstepA, voffA);
            PG8_WAIT_L(8); PG8_BAR; PG8_WAIT_L(0); PG8_MMA(0, 0, At, B0); PG8_BAR; PG8_SCHED;
            PG8_LDB(B1, 1, 1); PG8_STAGE(PG8_SB(1, 0), b3, voffB);
            PG8_BAR; PG8_WAIT_L(0); PG8_MMA(0, 1, At, B1); PG8_BAR;
            PG8_LDA(At, 1, 1); PG8_STAGEA(PG8_SA(1, 0), a3, voffA);
            PG8_BAR; PG8_WAIT_L(0); PG8_MMA(1, 0, At, B0); PG8_BAR; PG8_SCHED;
            PG8_STAGE(PG8_SB(1, 1), b3 + hstepB, voffB);
            PG8_WAIT_V(6); PG8_BAR; PG8_MMA(1, 1, At, B1); PG8_BAR;
            }
        }
        if constexpr (ALIGN_EPI) { if (wr == 0) PG8_BAR; }
        if constexpr (!Epi::AFTER_DRAIN) { E(acc, cur, wr, wc, fr, fq); S.done(cur); }
        if (!has_next) break;
#pragma unroll
        for (int a = 0; a < 2; ++a)
#pragma unroll
            for (int b = 0; b < 2; ++b)
#pragma unroll
                for (int m = 0; m < MT; ++m)
#pragma unroll
                    for (int n = 0; n < 2; ++n) acc[a][b][m][n] = (f32x4){0.f, 0.f, 0.f, 0.f};
        cur = nxt; cA = nA; cB = nB; ++ui;
        if constexpr (ALIGN_EPI) { if (wr == 1) PG8_BAR; }
    }
    PG8_WAIT_V(0);
    if constexpr (!ALIGN_EPI) { if (wr == 0) PG8_BAR; }
    PG8_BAR;
    if constexpr (Epi::AFTER_DRAIN) { E.fused(acc, cur, wr, wc, fr, fq, lds, wid, lane); S.done(cur); }
#undef PG8_SA
#undef PG8_SB
#undef PG8_STAGE
#undef PG8_LDA
#undef PG8_LDB
#undef PG8_MMA
#undef PG8_WAIT_V
#undef PG8_WAIT_VA
#undef PG8_STAGEA
#undef PG8_WAIT_L
#undef PG8_BAR
#undef PG8_SCHED
}
}
#define GAS __attribute__((address_space(1)))
#define LAS __attribute__((address_space(3)))
typedef unsigned short bf16;
typedef unsigned v4u __attribute__((ext_vector_type(4)));
typedef float f32x4 __attribute__((ext_vector_type(4)));
typedef short bf16x8 __attribute__((ext_vector_type(8)));
typedef GAS unsigned gu32;
typedef GAS unsigned long long gu64;
#define RLX_AGENT __ATOMIC_RELAXED, __HIP_MEMORY_SCOPE_AGENT
#define LDS_WAIT() asm volatile("s_waitcnt lgkmcnt(0)" ::: "memory")
#define VM_WAIT() asm volatile("s_waitcnt vmcnt(0)" ::: "memory")
__device__ __forceinline__ unsigned long long rt() { return __builtin_amdgcn_s_memrealtime(); }
__device__ __forceinline__ unsigned f2bf(float f) { unsigned u = __builtin_bit_cast(unsigned, f); return (u + 0x7fffu + ((u >> 16) & 1u)) >> 16; }
__device__ __forceinline__ unsigned pk2(float lo, float hi) { return f2bf(lo) | (f2bf(hi) << 16); }

#define XB_TMO      128
#define XB_XCNT(j)  (256  + 64 * (j))
#define XB_XSUB(j)  (1280 + 64 * (j))
#define XB_XGEN(j)  (2304 + 64 * (j))
#define XB_TOP      3328
#define XB_TOPGEN   3392
#define XCD_BAR_WORDS 3456
#define XB_SPIN_CAP (1u << 18)

__device__ __forceinline__ unsigned xb_ld(unsigned* p)              { return __hip_atomic_load(p, __ATOMIC_RELAXED, __HIP_MEMORY_SCOPE_AGENT); }
__device__ __forceinline__ unsigned xb_add(unsigned* p, unsigned v) { return __hip_atomic_fetch_add(p, v, __ATOMIC_RELAXED, __HIP_MEMORY_SCOPE_AGENT); }
__device__ __forceinline__ unsigned xb_xcc_id() { return (unsigned)__builtin_amdgcn_s_getreg((3 << 11) | 20) & 0xFu; }
#define XB_SPIN(cond, bar) do { unsigned _sp = 0; while (cond) { __builtin_amdgcn_s_sleep(1); \
    if ((++_sp & 255u) == 0u) { if (xb_ld(&(bar)[XB_TMO])) break; if (_sp > XB_SPIN_CAP) { atomicAdd(&(bar)[XB_TMO], 1u); break; } } } } while (0)

struct XcdBarrier {
    unsigned* bar; unsigned x;
    volatile LAS unsigned* st;
};

__device__ __forceinline__ XcdBarrier xcd_barrier_post(unsigned* bar, volatile LAS unsigned* st) {
    XcdBarrier b; b.bar = bar; b.x = xb_xcc_id(); b.st = st;
    if (threadIdx.x == 0) (void)xb_add(&bar[XB_XCNT(b.x)], 1u);
    return b;
}
__device__ __forceinline__ void xcd_barrier_complete(unsigned* bar, unsigned x, unsigned& nloc, unsigned& nx) {
    const unsigned G = gridDim.x * gridDim.y * gridDim.z;
    unsigned sum, cnt, mine, sp = 0u;
    for (;;) {
        sum = 0u; cnt = 0u; mine = 0u;
#pragma unroll
        for (unsigned j = 0; j < 16; ++j) { const unsigned c = xb_ld(&bar[XB_XCNT(j)]); sum += c; cnt += (c > 0u) ? 1u : 0u; mine = (j == x) ? c : mine; }
        if (sum == G) break;
        __builtin_amdgcn_s_sleep(1);
        if ((++sp & 255u) == 0u) { if (xb_ld(&bar[XB_TMO])) break; if (sp > XB_SPIN_CAP) { atomicAdd(&bar[XB_TMO], 1u); break; } }
    }
    nloc = mine > 0u ? mine : 1u; nx = cnt > 0u ? cnt : 1u;
}

__device__ __forceinline__ void xcd_barrier(const XcdBarrier& b) {
    asm volatile("s_waitcnt vmcnt(0)" ::: "memory");
    __syncthreads();
    if (threadIdx.x == 0) {
        unsigned* bar = b.bar;
        __builtin_amdgcn_s_waitcnt(0);
        unsigned nloc = b.st[0], nx = b.st[1];
        if (nloc == 0u) { xcd_barrier_complete(bar, b.x, nloc, nx); b.st[0] = nloc; b.st[1] = nx; }
        const unsigned old = xb_add(&bar[XB_XSUB(b.x)], 1u);
        const unsigned gen = old / nloc;
        if (old + 1u == (gen + 1u) * nloc) {
            __builtin_amdgcn_fence(__ATOMIC_RELEASE, "agent");
            asm volatile("s_waitcnt vmcnt(0)" ::: "memory");
            const unsigned og = xb_add(&bar[XB_TOP], 1u);
            const unsigned tg = og / nx;
            if (og + 1u == (tg + 1u) * nx) xb_add(&bar[XB_TOPGEN], 1u);
            else XB_SPIN(xb_ld(&bar[XB_TOPGEN]) == tg, bar);
            __builtin_amdgcn_fence(__ATOMIC_ACQUIRE, "agent");
            xb_add(&bar[XB_XGEN(b.x)], 1u);
            asm volatile("s_waitcnt vmcnt(0)" ::: "memory");
        } else {
            XB_SPIN(xb_ld(&bar[XB_XGEN(b.x)]) == gen, bar);
            __builtin_amdgcn_fence(__ATOMIC_ACQUIRE, "agent");
            asm volatile("s_waitcnt vmcnt(0)" ::: "memory");
        }
    }
    __syncthreads();
}
namespace mk {
typedef float f32x16 __attribute__((ext_vector_type(16)));
typedef float f32x2_t __attribute__((ext_vector_type(2)));
typedef __bf16 bf16x2_t __attribute__((ext_vector_type(2)));

constexpr int DM = 1024, M_CTX = 4096, MT = 12288, NL = 4, NPROJP = 2048, DFF = 4096, NGT = 384, GT_LAT0 = 128;
constexpr float EPS = 1e-6f, LOG2E = 1.4426950408889634f, NEGBIG = -1e30f;
constexpr int C_NAQ = 0, C_NAK = 256, C_NAV = 512, C_POOL = 768, C_CQ = 1024, C_CKV = 1280, C_KPE = 1408, C_SQ = 1440, C_SK = 1696, C_SV = 1824;

constexpr size_t MiB = 1u << 20;
constexpr size_t WS_CTL = 0, CTL_ZERO_BYTES = 64 * 1024;
constexpr size_t WS_TAB = 1 * MiB;
constexpr size_t WS_MOD = 2 * MiB;
constexpr size_t WS_BA = 3 * MiB;
constexpr size_t WS_BD = 4 * MiB;
constexpr size_t WS_PARTA = 5 * MiB;
constexpr size_t WS_PARTD = 6 * MiB;
constexpr size_t WS_WUQ = 7 * MiB;
constexpr size_t WS_WUKV = 8 * MiB;
constexpr size_t WS_WPOOL = 9 * MiB;
constexpr size_t WS_WIN = 10 * MiB;
constexpr size_t WS_WOUT = 26 * MiB;
constexpr size_t WS_W1 = 34 * MiB;
constexpr size_t WS_W2 = 66 * MiB;
constexpr size_t WS_CKNA = 98 * MiB;
constexpr size_t WS_CVNA = 102 * MiB;
constexpr size_t WS_CKS = 106 * MiB;
constexpr size_t WS_CVS = 108 * MiB;
constexpr size_t WS_CKM = 110 * MiB;
constexpr size_t WS_CVM = 116 * MiB;
constexpr size_t WS_X = 120 * MiB;
constexpr size_t WS_XS = 168 * MiB;
constexpr size_t WS_MIX = 192 * MiB;
constexpr size_t WS_P = 216 * MiB;
constexpr size_t WS_QNA = 264 * MiB;
constexpr size_t WS_KNA = 270 * MiB;
constexpr size_t WS_VNA = 276 * MiB;
constexpr size_t WS_QM = 282 * MiB;
constexpr size_t WS_KM = 291 * MiB;
constexpr size_t WS_VM = 300 * MiB;
constexpr size_t WS_QS = 306 * MiB;
constexpr size_t WS_KS = 312 * MiB;
constexpr size_t WS_VS = 315 * MiB;
constexpr size_t WS_Z = 216 * MiB;
constexpr size_t WS_END = 318 * MiB;

constexpr size_t O_Y = 0, O_NAK = 12582912, O_NAV = 16777216, O_CKV = 20971520, O_KPE = 23068672, O_SK = 23592960, O_SV = 25690112;

struct Args { const float* in[32]; float* out; unsigned char* ws; };

__device__ __forceinline__ unsigned cvtpk(float lo, float hi) { f32x2_t v = {lo, hi}; bf16x2_t b = __builtin_convertvector(v, bf16x2_t); return __builtin_bit_cast(unsigned, b); }
__device__ __forceinline__ float bflo(unsigned w) { return __uint_as_float(w << 16); }
__device__ __forceinline__ float bfhi(unsigned w) { return __uint_as_float(w & 0xffff0000u); }
__device__ __forceinline__ int swz(int x) { return (x & ~12) | ((x & 4) << 1) | ((x & 8) >> 1); }
__device__ __forceinline__ f32x16 mfma32(bf16x8 a, bf16x8 b, f32x16 c) { return __builtin_amdgcn_mfma_f32_32x32x16_bf16(a, b, c, 0, 0, 0); }
__device__ __forceinline__ bf16x8 pack8(float a0, float a1, float a2, float a3, float a4, float a5, float a6, float a7) {
    v4u w; w.x = cvtpk(a0, a1); w.y = cvtpk(a2, a3); w.z = cvtpk(a4, a5); w.w = cvtpk(a6, a7); return __builtin_bit_cast(bf16x8, w); }
#define PACK8ARR(a, o) pack8((a)[(o)], (a)[(o) + 1], (a)[(o) + 2], (a)[(o) + 3], (a)[(o) + 4], (a)[(o) + 5], (a)[(o) + 6], (a)[(o) + 7])
__device__ __forceinline__ size_t pblk(int row, int col) { return ((size_t)((row >> 5) * 256 + (col >> 3)) << 8) + (size_t)(((row & 31) << 3) + (col & 7)); }
template <bool F32> __device__ __forceinline__ size_t sidx(int row, size_t pitch, int col) { return F32 ? (size_t)row * pitch + (size_t)col : pblk(row, col); }
template <bool F32> __device__ __forceinline__ void load8(const void* base, size_t elem, float (&f)[8]) {
    if (F32) { const f32x4* p = (const f32x4*)((const float*)base + elem); const f32x4 a = p[0], b = p[1];
        f[0] = a[0]; f[1] = a[1]; f[2] = a[2]; f[3] = a[3]; f[4] = b[0]; f[5] = b[1]; f[6] = b[2]; f[7] = b[3]; }
    else { const v4u w = *(const v4u*)((const bf16*)base + elem);
        f[0] = bflo(w.x); f[1] = bfhi(w.x); f[2] = bflo(w.y); f[3] = bfhi(w.y); f[4] = bflo(w.z); f[5] = bfhi(w.z); f[6] = bflo(w.w); f[7] = bfhi(w.w); }
}
__device__ __forceinline__ void store8f(float* p, const float (&f)[8]) { ((f32x4*)p)[0] = (f32x4){f[0], f[1], f[2], f[3]}; ((f32x4*)p)[1] = (f32x4){f[4], f[5], f[6], f[7]}; }

struct TokInfo { int lat; int b; int t; };
__device__ __forceinline__ TokInfo tok_info(int row) { TokInfo r; if (row < M_CTX) { r.lat = 0; r.b = row >> 8; r.t = row & 255; } else { r.lat = 1; r.b = (row - M_CTX) >> 11; r.t = (row - M_CTX) & 2047; } return r; }


template <bool F32, bool NORM>
__device__ __forceinline__ void head_norm_task(const void* src, size_t pitch, int row0, int col, const float* gain, bool isK, float oscale,
                                               const float* ropeS, int prow, int pcol, bf16* dst  , int tile, float* fout  , int lane) {
    const int tok = lane & 31;
    float v[64];
#pragma unroll
    for (int c = 0; c < 8; ++c) { float f[8]; load8<F32>(src, sidx<F32>(row0 + tok, pitch, col + 8 * c), f);
#pragma unroll
        for (int e = 0; e < 8; ++e) v[8 * c + e] = f[e]; }
    if (NORM) {
        float ss = 0.f;
#pragma unroll
        for (int d = 0; d < 64; ++d) ss += v[d] * v[d];
        const float rs = 1.0f / sqrtf(ss * (1.0f / 64.0f) + EPS);
#pragma unroll
        for (int d = 0; d < 64; ++d) v[d] = v[d] * rs * gain[d];
    }
    if (fout) {
#pragma unroll
        for (int c = 0; c < 16; ++c) ((f32x4*)fout)[c] = (f32x4){v[4 * c], v[4 * c + 1], v[4 * c + 2], v[4 * c + 3]};
    }
    if (ropeS) {
#pragma unroll
        for (int i = 0; i < 16; ++i) {
            const float cr = ropeS[prow * 16 + i], sr = ropeS[1024 + prow * 16 + i], cc = ropeS[pcol * 16 + i], sc = ropeS[1024 + pcol * 16 + i];
            const float a1 = v[i], a2 = v[16 + i], b1 = v[32 + i], b2 = v[48 + i];
            v[i] = a1 * cr - a2 * sr; v[16 + i] = a1 * sr + a2 * cr; v[32 + i] = b1 * cc - b2 * sc; v[48 + i] = b1 * sc + b2 * cc;
        }
    }
    if (oscale != 1.0f) {
#pragma unroll
        for (int d = 0; d < 64; ++d) v[d] *= oscale;
    }
    const int slot = isK ? swz(tok) : tok;
    bf16* d0 = dst + (size_t)tile * 2048;
#pragma unroll
    for (int c = 0; c < 4; ++c)
#pragma unroll
        for (int hf = 0; hf < 2; ++hf) *(bf16x8*)(d0 + c * 512 + (hf * 32 + slot) * 8) = PACK8ARR(v, 16 * c + 8 * hf);
}

template <bool F32>
__device__ __forceinline__ void vtrans_task(const void* src, size_t pitch, int row0, int col, bf16* dst  , int tile, float* fout, int fpitch, int lane) {
    const int i = lane & 31, kh = lane >> 5; const int tokp = swz(i);
    bf16x8 af[4];
#pragma unroll
    for (int kc = 0; kc < 4; ++kc) { float f[8]; load8<F32>(src, sidx<F32>(row0 + tokp, pitch, col + 16 * kc + 8 * kh), f);
        if (fout) store8f(fout + (size_t)tokp * fpitch + 16 * kc + 8 * kh, f);
        af[kc] = PACK8ARR(f, 0); }
    v4u i0 = {0u, 0u, 0u, 0u}, i1 = {0u, 0u, 0u, 0u};
    { const int j0 = i - 8 * kh; const int j1 = i - 16 - 8 * kh;
      unsigned w0[4] = {0u, 0u, 0u, 0u}, w1[4] = {0u, 0u, 0u, 0u};
#pragma unroll
      for (int j = 0; j < 8; ++j) { const unsigned one = 0x3F80u << (16 * (j & 1)); if (j0 == j) w0[j >> 1] |= one; if (j1 == j) w1[j >> 1] |= one; }
      i0 = (v4u){w0[0], w0[1], w0[2], w0[3]}; i1 = (v4u){w1[0], w1[1], w1[2], w1[3]}; }
    const bf16x8 I0 = __builtin_bit_cast(bf16x8, i0), I1 = __builtin_bit_cast(bf16x8, i1);
    bf16* d0 = dst + (size_t)tile * 2048;
#pragma unroll
    for (int ft = 0; ft < 2; ++ft) {
        f32x16 acc = {0.f, 0.f, 0.f, 0.f, 0.f, 0.f, 0.f, 0.f, 0.f, 0.f, 0.f, 0.f, 0.f, 0.f, 0.f, 0.f};
        acc = mfma32(af[2 * ft], I0, acc); acc = mfma32(af[2 * ft + 1], I1, acc);
#pragma unroll
        for (int s = 0; s < 2; ++s) *(bf16x8*)(d0 + ((ft * 2 + s) * 64 + lane) * 8) = PACK8ARR(acc, 8 * s);
    }
}

__device__ __forceinline__ void rope_tail32(float (&t0)[8], float (&t1)[8], const float* ropeM, int prow, int pcol, int h2) {
#pragma unroll
    for (int e = 0; e < 8; ++e) {
        const float p0 = __shfl_xor(t0[e], 32), p1 = __shfl_xor(t1[e], 32);
        const float cr = ropeM[prow * 8 + e], sr = ropeM[512 + prow * 8 + e], cc = ropeM[pcol * 8 + e], sc = ropeM[512 + pcol * 8 + e];
        t0[e] = t0[e] * cr + (h2 ? p0 : -p0) * sr;
        t1[e] = t1[e] * cc + (h2 ? p1 : -p1) * sc;
    }
}

__device__ __forceinline__ void mla_q_task(const bf16* P, int row0, const float* ga  , const bf16* wuqT  , const LAS bf16x8* wl  , int head, const float* gq  ,
                                           const float* ropeM, bf16* dst  , int tile, int lane) {
    const int tok = lane & 31, kh = lane >> 5; const int row = row0 + tok;
    bf16x8 bfr[16]; float ss = 0.f;
    {
        v4u raw[16];
#pragma unroll
        for (int kc = 0; kc < 16; ++kc) raw[kc] = *(const v4u*)(P + pblk(row, C_CQ + 16 * kc + 8 * kh));
#pragma unroll
        for (int kc = 0; kc < 16; ++kc) { const v4u w = raw[kc];
            ss += (bflo(w.x) * bflo(w.x) + bfhi(w.x) * bfhi(w.x)) + (bflo(w.y) * bflo(w.y) + bfhi(w.y) * bfhi(w.y)) + (bflo(w.z) * bflo(w.z) + bfhi(w.z) * bfhi(w.z)) + (bflo(w.w) * bflo(w.w) + bfhi(w.w) * bfhi(w.w)); }
        ss += __shfl_xor(ss, 32);
        const float rs = 1.0f / sqrtf(ss * (1.0f / 256.0f) + EPS);
#pragma unroll
        for (int kc = 0; kc < 16; ++kc) { const v4u w = raw[kc];
            if (wl) bfr[kc] = pack8(bflo(w.x) * rs, bfhi(w.x) * rs, bflo(w.y) * rs, bfhi(w.y) * rs, bflo(w.z) * rs, bfhi(w.z) * rs, bflo(w.w) * rs, bfhi(w.w) * rs);
            else { const f32x4 g0 = *(const f32x4*)(ga + 16 * kc + 8 * kh), g1 = *(const f32x4*)(ga + 16 * kc + 8 * kh + 4);
                bfr[kc] = pack8(bflo(w.x) * rs * g0[0], bfhi(w.x) * rs * g0[1], bflo(w.y) * rs * g0[2], bfhi(w.y) * rs * g0[3], bflo(w.z) * rs * g1[0], bfhi(w.z) * rs * g1[1], bflo(w.w) * rs * g1[2], bfhi(w.w) * rs * g1[3]); } }
        __builtin_amdgcn_sched_barrier(0);
    }
    f32x16 acc[3];
#pragma unroll
    for (int ft = 0; ft < 3; ++ft) {
        acc[ft] = (f32x16){0.f, 0.f, 0.f, 0.f, 0.f, 0.f, 0.f, 0.f, 0.f, 0.f, 0.f, 0.f, 0.f, 0.f, 0.f, 0.f};
        const bf16* wr = wuqT + (size_t)(head * 96 + 32 * ft + swz(tok)) * 256 + 8 * kh;
#pragma unroll
        for (int k8 = 0; k8 < 16; k8 += 8) { bf16x8 wv[8];
#pragma unroll
            for (int kc = 0; kc < 8; ++kc) wv[kc] = wl ? wl[(ft * 16 + k8 + kc) * 64 + lane] : *(const bf16x8*)(wr + 16 * (k8 + kc));
#pragma unroll
            for (int kc = 0; kc < 8; ++kc) acc[ft] = mfma32(wv[kc], bfr[k8 + kc], acc[ft]); }
    }
    float s2 = 0.f;
#pragma unroll
    for (int ft = 0; ft < 3; ++ft)
#pragma unroll
        for (int r = 0; r < 16; ++r) s2 += acc[ft][r] * acc[ft][r];
    s2 += __shfl_xor(s2, 32);
    const float rq = (0.10206207261596577f * LOG2E) / sqrtf(s2 * (1.0f / 96.0f) + EPS);
    const TokInfo ti = tok_info(row);
    bf16* d0 = dst + (size_t)tile * 3072;
#pragma unroll
    for (int ft = 0; ft < 3; ++ft) {
        float o0[8], o1[8];
        const f32x4 ga0 = *(const f32x4*)(gq + 32 * ft + 8 * kh), ga1 = *(const f32x4*)(gq + 32 * ft + 8 * kh + 4), gb0 = *(const f32x4*)(gq + 32 * ft + 16 + 8 * kh), gb1 = *(const f32x4*)(gq + 32 * ft + 16 + 8 * kh + 4);
#pragma unroll
        for (int e = 0; e < 4; ++e) { o0[e] = acc[ft][e] * rq * ga0[e]; o0[4 + e] = acc[ft][4 + e] * rq * ga1[e]; o1[e] = acc[ft][8 + e] * rq * gb0[e]; o1[4 + e] = acc[ft][12 + e] * rq * gb1[e]; }
        if (ft == 2 && ti.lat) rope_tail32(o0, o1, ropeM, ti.t >> 6, ti.t & 63, kh);
        *(bf16x8*)(d0 + (2 * ft) * 512 + (kh * 32 + tok) * 8) = PACK8ARR(o0, 0);
        *(bf16x8*)(d0 + (2 * ft + 1) * 512 + (kh * 32 + tok) * 8) = PACK8ARR(o1, 0);
    }
}

template <bool F32, bool NORM>
__device__ __forceinline__ void mla_kv_task(const void* ckv_src, size_t ckv_pitch, size_t ckv_col, const void* kpe_src, size_t kpe_pitch, size_t kpe_col, int row0,
                                            const float* gkv  , const bf16* wukvT  , const LAS bf16x8* wl  , int head, const float* gk  , const float* ropeM, int seq_t0  ,
                                            bf16* kdst  , bf16* vdst  , int tile, float* ckv_out, float* kpe_out, int lane) {
    const int tok = lane & 31, kh = lane >> 5; const int row = row0 + tok;
    bf16x8 bfr[8];
    {
        float cv[8][8]; float ss = 0.f;
#pragma unroll
        for (int kc = 0; kc < 8; ++kc) { load8<F32>(ckv_src, sidx<F32>(row, ckv_pitch, (int)ckv_col + 16 * kc + 8 * kh), cv[kc]);
#pragma unroll
            for (int e = 0; e < 8; ++e) ss += cv[kc][e] * cv[kc][e]; }
        if (NORM) {
            ss += __shfl_xor(ss, 32);
            const float rs = 1.0f / sqrtf(ss * (1.0f / 128.0f) + EPS);
#pragma unroll
            for (int kc = 0; kc < 8; ++kc) { const f32x4 g0 = *(const f32x4*)(gkv + 16 * kc + 8 * kh), g1 = *(const f32x4*)(gkv + 16 * kc + 8 * kh + 4);
#pragma unroll
                for (int e = 0; e < 4; ++e) { cv[kc][e] = cv[kc][e] * rs * g0[e]; cv[kc][4 + e] = cv[kc][4 + e] * rs * g1[e]; } }
        }
#pragma unroll
        for (int kc = 0; kc < 8; ++kc) { if (ckv_out) store8f(ckv_out + (size_t)tok * 128 + 16 * kc + 8 * kh, cv[kc]); bfr[kc] = PACK8ARR(cv[kc], 0); }
    }
    __builtin_amdgcn_sched_barrier(0);
    f32x16 an[2];
#pragma unroll
    for (int ft = 0; ft < 2; ++ft) {
        an[ft] = (f32x16){0.f, 0.f, 0.f, 0.f, 0.f, 0.f, 0.f, 0.f, 0.f, 0.f, 0.f, 0.f, 0.f, 0.f, 0.f, 0.f};
        const bf16* wr = wukvT + (size_t)(head * 128 + 32 * ft + swz(tok)) * 128 + 8 * kh;
        { bf16x8 wv[8];
#pragma unroll
          for (int kc = 0; kc < 8; ++kc) wv[kc] = wl ? wl[(ft * 8 + kc) * 64 + lane] : *(const bf16x8*)(wr + 16 * kc);
#pragma unroll
          for (int kc = 0; kc < 8; ++kc) an[ft] = mfma32(wv[kc], bfr[kc], an[ft]); }
    }
    __builtin_amdgcn_sched_barrier(0);
    float t0[8], t1[8];
    load8<F32>(kpe_src, sidx<F32>(row, kpe_pitch, (int)kpe_col + 8 * kh), t0);
    load8<F32>(kpe_src, sidx<F32>(row, kpe_pitch, (int)kpe_col + 16 + 8 * kh), t1);
    if (kpe_out) { store8f(kpe_out + (size_t)tok * 32 + 8 * kh, t0); store8f(kpe_out + (size_t)tok * 32 + 16 + 8 * kh, t1); }
    float s2 = 0.f;
#pragma unroll
    for (int ft = 0; ft < 2; ++ft)
#pragma unroll
        for (int r = 0; r < 16; ++r) s2 += an[ft][r] * an[ft][r];
#pragma unroll
    for (int e = 0; e < 8; ++e) s2 += t0[e] * t0[e] + t1[e] * t1[e];
    s2 += __shfl_xor(s2, 32);
    const float rk = 1.0f / sqrtf(s2 * (1.0f / 96.0f) + EPS);
    const int slot = kh * 32 + swz(tok);
    bf16* kd = kdst + (size_t)tile * 3072;
#pragma unroll
    for (int ft = 0; ft < 2; ++ft) {
        float o0[8], o1[8];
        const f32x4 ga0 = *(const f32x4*)(gk + 32 * ft + 8 * kh), ga1 = *(const f32x4*)(gk + 32 * ft + 8 * kh + 4), gb0 = *(const f32x4*)(gk + 32 * ft + 16 + 8 * kh), gb1 = *(const f32x4*)(gk + 32 * ft + 16 + 8 * kh + 4);
#pragma unroll
        for (int e = 0; e < 4; ++e) { o0[e] = an[ft][e] * rk * ga0[e]; o0[4 + e] = an[ft][4 + e] * rk * ga1[e]; o1[e] = an[ft][8 + e] * rk * gb0[e]; o1[4 + e] = an[ft][12 + e] * rk * gb1[e]; }
        *(bf16x8*)(kd + (2 * ft) * 512 + slot * 8) = PACK8ARR(o0, 0);
        *(bf16x8*)(kd + (2 * ft + 1) * 512 + slot * 8) = PACK8ARR(o1, 0);
    }
    {
        const f32x4 ga0 = *(const f32x4*)(gk + 64 + 8 * kh), ga1 = *(const f32x4*)(gk + 64 + 8 * kh + 4), gb0 = *(const f32x4*)(gk + 80 + 8 * kh), gb1 = *(const f32x4*)(gk + 80 + 8 * kh + 4);
#pragma unroll
        for (int e = 0; e < 4; ++e) { t0[e] = t0[e] * rk * ga0[e]; t0[4 + e] = t0[4 + e] * rk * ga1[e]; t1[e] = t1[e] * rk * gb0[e]; t1[4 + e] = t1[4 + e] * rk * gb1[e]; }
        if (ropeM) { const int t = seq_t0 + tok; rope_tail32(t0, t1, ropeM, t >> 6, t & 63, kh); }
        *(bf16x8*)(kd + 4 * 512 + slot * 8) = PACK8ARR(t0, 0);
        *(bf16x8*)(kd + 5 * 512 + slot * 8) = PACK8ARR(t1, 0);
    }
    __builtin_amdgcn_sched_barrier(0);
    bf16x8 afr[8];
    { const int srcl = kh * 32 + swz(tok);
#pragma unroll
      for (int kc = 0; kc < 8; ++kc) { const v4u w = __builtin_bit_cast(v4u, bfr[kc]); v4u o;
          o.x = (unsigned)__shfl((int)w.x, srcl); o.y = (unsigned)__shfl((int)w.y, srcl); o.z = (unsigned)__shfl((int)w.z, srcl); o.w = (unsigned)__shfl((int)w.w, srcl);
          afr[kc] = __builtin_bit_cast(bf16x8, o); } }
    bf16* vd = vdst + (size_t)tile * 2048;
#pragma unroll
    for (int dvt = 0; dvt < 2; ++dvt) {
        f32x16 av = {0.f, 0.f, 0.f, 0.f, 0.f, 0.f, 0.f, 0.f, 0.f, 0.f, 0.f, 0.f, 0.f, 0.f, 0.f, 0.f};
        const bf16* wr = wukvT + (size_t)(head * 128 + 64 + 32 * dvt + tok) * 128 + 8 * kh;
        { bf16x8 wv[8];
#pragma unroll
          for (int kc = 0; kc < 8; ++kc) wv[kc] = wl ? wl[(16 + dvt * 8 + kc) * 64 + lane] : *(const bf16x8*)(wr + 16 * kc);
#pragma unroll
          for (int kc = 0; kc < 8; ++kc) av = mfma32(afr[kc], wv[kc], av); }
#pragma unroll
        for (int s = 0; s < 2; ++s) *(bf16x8*)(vd + ((dvt * 2 + s) * 64 + lane) * 8) = PACK8ARR(av, 8 * s);
    }
}

template <int DKC, int MODE, int NQ>
__device__ __forceinline__ void attn_range(float (&m)[NQ], float (&l)[NQ], f32x16 (&o)[NQ][2], const bf16x8 (&qf)[NQ][DKC], const bf16* Kb, const bf16* Vb, int ta, int tb, int lane,
                                           int seqtile0, int tq0, const LAS float* rpb_h) {
    const int hh = lane >> 5;
    bf16x8 kf[DKC];
    { const bf16x8* kp = (const bf16x8*)(Kb + (size_t)ta * (DKC * 512)) + lane;
#pragma unroll
      for (int c = 0; c < DKC; ++c) kf[c] = kp[c * 64]; }
    for (int t = ta; t < tb; ++t) {
        const bf16x8* vp = (const bf16x8*)(Vb + (size_t)t * 2048) + lane;
        const bf16x8 v00 = vp[0], v01 = vp[64], v10 = vp[128], v11 = vp[192];
        f32x16 s[NQ];
#pragma unroll
        for (int j = 0; j < NQ; ++j) { s[j] = (f32x16){0.f, 0.f, 0.f, 0.f, 0.f, 0.f, 0.f, 0.f, 0.f, 0.f, 0.f, 0.f, 0.f, 0.f, 0.f, 0.f};
#pragma unroll
            for (int c = 0; c < DKC; ++c) s[j] = mfma32(kf[c], qf[j][c], s[j]); }
        { const int tn = (t + 1 < tb) ? t + 1 : t; const bf16x8* kp = (const bf16x8*)(Kb + (size_t)tn * (DKC * 512)) + lane;
#pragma unroll
          for (int c = 0; c < DKC; ++c) kf[c] = kp[c * 64]; }
#pragma unroll
        for (int j = 0; j < NQ; ++j) {
            float p[16];
#pragma unroll
            for (int r = 0; r < 16; ++r) p[r] = s[j][r];
            if (MODE == 1) {
                const int tq = tq0 + 32 * j; const int rel = t - seqtile0, kr = rel >> 1, kcb = rel & 1; const int qr = tq >> 6, qc = tq & 63;
                int cs = qc - 8; cs = cs < 0 ? 0 : (cs > 48 ? 48 : cs);
                const int kb = 32 * kcb + 8 * hh;
                const LAS float* bp = rpb_h + ((kr - qr + 7) * 31 + kb - qc + 15);
                const int vb0 = kb - cs;
#pragma unroll
                for (int r = 0; r < 16; ++r) { const int cr = 16 * (r >> 3) + (r & 7); const bool valid = (unsigned)(vb0 + cr) < 16u; p[r] = valid ? p[r] + bp[cr] : NEGBIG; }
            } else if (MODE == 2) {
                const int sb = (t - seqtile0) * 32 + 8 * hh - (tq0 + 32 * j);
#pragma unroll
                for (int r = 0; r < 16; ++r) { const int d = sb + 16 * (r >> 3) + (r & 7); p[r] = (d <= 128 && d >= -128) ? p[r] : NEGBIG; }
            }
            float mx = fmaxf(fmaxf(p[0], p[1]), p[2]);
#pragma unroll
            for (int r = 3; r < 15; r += 2) mx = fmaxf(fmaxf(mx, p[r]), p[r + 1]);
            mx = fmaxf(mx, p[15]);
            mx = fmaxf(mx, __shfl_xor(mx, 32));
            const bool need = mx > m[j] + 8.0f;
            if (__any(need)) {
                const float mn = need ? mx : m[j]; const float alpha = __builtin_amdgcn_exp2f(m[j] - mn); m[j] = mn; l[j] *= alpha;
#pragma unroll
                for (int r = 0; r < 16; ++r) { o[j][0][r] *= alpha; o[j][1][r] *= alpha; }
            }
            const float mj = m[j]; float sum = 0.f;
#pragma unroll
            for (int r = 0; r < 16; ++r) { p[r] = __builtin_amdgcn_exp2f(p[r] - mj); sum += p[r]; }
            l[j] += sum;
            const bf16x8 pf0 = PACK8ARR(p, 0), pf1 = PACK8ARR(p, 8);
            o[j][0] = mfma32(v00, pf0, o[j][0]); o[j][0] = mfma32(v01, pf1, o[j][0]);
            o[j][1] = mfma32(v10, pf0, o[j][1]); o[j][1] = mfma32(v11, pf1, o[j][1]);
        }
    }
}

__device__ __forceinline__ void attn_store(float m, float l, const f32x16& o0, const f32x16& o1, bool has_sink, float sinkv, bf16* mix_row  , int lane) {
    typedef unsigned u32x2v __attribute__((ext_vector_type(2)));
    const int hh = lane >> 5;
    float lt = l + __shfl_xor(l, 32);
    if (has_sink) lt += __builtin_amdgcn_exp2f(sinkv * LOG2E - m);
    const float inv = 1.0f / lt;
#pragma unroll
    for (int g = 0; g < 4; ++g) {
        u32x2v w0, w1;
        w0.x = cvtpk(o0[4 * g] * inv, o0[4 * g + 1] * inv); w0.y = cvtpk(o0[4 * g + 2] * inv, o0[4 * g + 3] * inv);
        w1.x = cvtpk(o1[4 * g] * inv, o1[4 * g + 1] * inv); w1.y = cvtpk(o1[4 * g + 2] * inv, o1[4 * g + 3] * inv);
        *(u32x2v*)(mix_row + 8 * g + 4 * hh) = w0;
        *(u32x2v*)(mix_row + 32 + 8 * g + 4 * hh) = w1;
    }
}

template <int DKC, int NQ> __device__ __forceinline__ void load_q(bf16x8 (&qf)[NQ][DKC], const bf16* Qb  , int tile, int lane) {
#pragma unroll
    for (int j = 0; j < NQ; ++j) { const bf16x8* qp = (const bf16x8*)(Qb + (size_t)(tile + j) * (DKC * 512)) + lane;
#pragma unroll
        for (int c = 0; c < DKC; ++c) qf[j][c] = qp[c * 64]; }
}
#define ATTN_INIT(NQ_) float m[NQ_], lsum[NQ_]; f32x16 o[NQ_][2]; _Pragma("unroll") for (int j_ = 0; j_ < NQ_; ++j_) { m[j_] = NEGBIG; lsum[j_] = 0.f; \
    o[j_][0] = (f32x16){0.f, 0.f, 0.f, 0.f, 0.f, 0.f, 0.f, 0.f, 0.f, 0.f, 0.f, 0.f, 0.f, 0.f, 0.f, 0.f}; o[j_][1] = o[j_][0]; }


__device__ __forceinline__ void make_q64(bf16x8 (&qf)[2][4], const bf16* P, int tile, int col, const float* gain, float qscale, const float* ropeS  , int lane) {
    const int q = lane & 31, kh = lane >> 5;
    f32x4 g[4][2];
#pragma unroll
    for (int c = 0; c < 4; ++c) { g[c][0] = *(const f32x4*)(gain + 16 * c + 8 * kh); g[c][1] = *(const f32x4*)(gain + 16 * c + 8 * kh + 4); }
#pragma unroll
    for (int j = 0; j < 2; ++j) { const int row = (tile + j) * 32 + q;
        float v[4][8]; float ss = 0.f;
#pragma unroll
        for (int c = 0; c < 4; ++c) { load8<false>(P, pblk(row, col + 16 * c + 8 * kh), v[c]);
#pragma unroll
            for (int e = 0; e < 8; ++e) ss += v[c][e] * v[c][e]; }
        ss += __shfl_xor(ss, 32);
        const float rs = qscale / sqrtf(ss * (1.0f / 64.0f) + EPS);
#pragma unroll
        for (int c = 0; c < 4; ++c)
#pragma unroll
            for (int e = 0; e < 8; ++e) v[c][e] *= rs * g[c][e >> 2][e & 3];
        if (ropeS) { const TokInfo ti = tok_info(row); const int prow = ti.t >> 6, pcol = ti.t & 63;
#pragma unroll
            for (int e = 0; e < 8; ++e) { const int i = 8 * kh + e;
                const float cr = ropeS[prow * 16 + i], sr = ropeS[1024 + prow * 16 + i], cc = ropeS[pcol * 16 + i], sc = ropeS[1024 + pcol * 16 + i];
                const float a1 = v[0][e], a2 = v[1][e], b1 = v[2][e], b2 = v[3][e];
                v[0][e] = a1 * cr - a2 * sr; v[1][e] = a1 * sr + a2 * cr; v[2][e] = b1 * cc - b2 * sc; v[3][e] = b1 * sc + b2 * cc; } }
#pragma unroll
        for (int c = 0; c < 4; ++c) qf[j][c] = PACK8ARR(v[c], 0); }
}

__device__ __forceinline__ void pool_task(const bf16* P, const bf16* wp  , const float* pscale  , bf16* MIXb, int gt, int g, int lane) {
    const int tok = lane & 31, kh = lane >> 5; const int row = gt * 32 + tok; const TokInfo ti = tok_info(row);
    const int n = ti.lat ? 2048 : 256; const int w = 2 << g; const int rowbase = row - ti.t;
    const int colb = C_POOL + g * 64 + 8 * kh;
    float sum[4][8];
#pragma unroll
    for (int kc = 0; kc < 4; ++kc)
#pragma unroll
        for (int e = 0; e < 8; ++e) sum[kc][e] = 0.f;
    v4u ownr[4];
#pragma unroll
    for (int kc = 0; kc < 4; ++kc) ownr[kc] = *(const v4u*)(P + pblk(row, colb + 16 * kc));
    int cnt = 0;
    for (int j0 = 0; j0 < w; j0 += 4) {
        v4u raw[4][4]; float okf[4];
#pragma unroll
        for (int u = 0; u < 4; ++u) { const int s = ti.t - (w >> 1) + j0 + u; const bool ok = (j0 + u < w) && (s >= 0) && (s < n); okf[u] = ok ? 1.f : 0.f; cnt += ok ? 1 : 0; const int sr = ok ? s : ti.t;
#pragma unroll
            for (int kc = 0; kc < 4; ++kc) raw[u][kc] = *(const v4u*)(P + pblk(rowbase + sr, colb + 16 * kc)); }
#pragma unroll
        for (int u = 0; u < 4; ++u)
#pragma unroll
            for (int kc = 0; kc < 4; ++kc) { const v4u q = raw[u][kc]; const float k = okf[u];
                sum[kc][0] += k * bflo(q.x); sum[kc][1] += k * bfhi(q.x); sum[kc][2] += k * bflo(q.y); sum[kc][3] += k * bfhi(q.y);
                sum[kc][4] += k * bflo(q.z); sum[kc][5] += k * bfhi(q.z); sum[kc][6] += k * bflo(q.w); sum[kc][7] += k * bfhi(q.w); }
    }
    const float inv = 1.0f / (float)cnt;
    bf16x8 bfr[4];
#pragma unroll
    for (int kc = 0; kc < 4; ++kc) { const v4u q = ownr[kc];
        bfr[kc] = pack8(sum[kc][0] * inv - bflo(q.x), sum[kc][1] * inv - bfhi(q.x), sum[kc][2] * inv - bflo(q.y), sum[kc][3] * inv - bfhi(q.y),
                        sum[kc][4] * inv - bflo(q.z), sum[kc][5] * inv - bfhi(q.z), sum[kc][6] * inv - bflo(q.w), sum[kc][7] * inv - bfhi(q.w)); }
#pragma unroll
    for (int ft = 0; ft < 2; ++ft) {
        f32x16 acc = {0.f, 0.f, 0.f, 0.f, 0.f, 0.f, 0.f, 0.f, 0.f, 0.f, 0.f, 0.f, 0.f, 0.f, 0.f, 0.f};
        const bf16* wr = wp + (size_t)(32 * ft + swz(tok)) * 64 + 8 * kh;
#pragma unroll
        for (int kc = 0; kc < 4; ++kc) acc = mfma32(*(const bf16x8*)(wr + 16 * kc), bfr[kc], acc);
#pragma unroll
        for (int s = 0; s < 2; ++s) { const float* ps = pscale + 32 * ft + 16 * s + 8 * kh; const f32x4 s0 = *(const f32x4*)ps, s1 = *(const f32x4*)(ps + 4);
            *(bf16x8*)(MIXb + (size_t)row * 1024 + 256 + g * 64 + 32 * ft + 16 * s + 8 * kh) =
                pack8(acc[8 * s] * s0[0], acc[8 * s + 1] * s0[1], acc[8 * s + 2] * s0[2], acc[8 * s + 3] * s0[3], acc[8 * s + 4] * s1[0], acc[8 * s + 5] * s1[1], acc[8 * s + 6] * s1[2], acc[8 * s + 7] * s1[3]); }
    }
}
}
#ifndef REP_MLA
#define REP_MLA 1
#endif
#ifndef REP_OTH
#define REP_OTH 1
#endif
#ifndef REP_A
#define REP_A 1
#endif
#ifndef REP_A2
#define REP_A2 1
#endif
#ifndef REP_B
#define REP_B 1
#endif
#ifndef REP_D
#define REP_D 1
#endif
namespace mk {
constexpr int NWAVES = 8, NTHR = 512;
constexpr int RING_BYTES = 131072, LDSCTL_OFF = RING_BYTES, LDS_BYTES = 147456;

__device__ __forceinline__ float wave_sum(float v) {
#pragma unroll
    for (int o = 1; o < 64; o <<= 1) v += __shfl_xor(v, o);
    return v;
}

__device__ __forceinline__ void transpose_item(const float* W, int K, int N, bf16* WT, int row_off, LAS float* scr, int item, int lane) {
    const int nblk = N / 32, kb = item / nblk, nb = item % nblk, k0 = 64 * kb, n0 = 32 * nb;
    float tv[32];
#pragma unroll
    for (int i = 0; i < 32; ++i) tv[i] = __builtin_nontemporal_load(&W[(size_t)(k0 + 2 * i + (lane >> 5)) * N + n0 + (lane & 31)]);
#pragma unroll
    for (int i = 0; i < 32; ++i) scr[(2 * i + (lane >> 5)) * 33 + (lane & 31)] = tv[i];
    asm volatile("s_waitcnt lgkmcnt(0)" ::: "memory");
    const int c = lane & 7;
#pragma unroll
    for (int j = 0; j < 4; ++j) { const int n = (lane >> 3) + 8 * j; const LAS float* s = scr + (8 * c) * 33 + n;
        v4u o; o.x = cvtpk(s[0 * 33], s[1 * 33]); o.y = cvtpk(s[2 * 33], s[3 * 33]); o.z = cvtpk(s[4 * 33], s[5 * 33]); o.w = cvtpk(s[6 * 33], s[7 * 33]);
        *(v4u*)(WT + (size_t)(row_off + n0 + n) * K + k0 + 8 * c) = o; }
    asm volatile("s_waitcnt lgkmcnt(0)" ::: "memory");
}

__device__ __forceinline__ void gemv5_item(const float* W, int N, int c0, const LAS float* vec, LAS float* red, float* out, int ldo, const float* bias, int tid) {
    const int kq = tid >> 3, c4 = (tid & 7) * 4;
    const float* wp = W + (size_t)(kq * 16) * N + c0 + c4;
    f32x4 wv[16];
#pragma unroll
    for (int k = 0; k < 16; ++k) wv[k] = __builtin_nontemporal_load((const f32x4*)(wp + (size_t)k * N));
    f32x4 acc[5];
#pragma unroll
    for (int mi = 0; mi < 5; ++mi) acc[mi] = (f32x4){0.f, 0.f, 0.f, 0.f};
#pragma unroll
    for (int k = 0; k < 16; ++k) {
#pragma unroll
        for (int mi = 0; mi < 5; ++mi) acc[mi] += wv[k] * vec[mi * 1024 + kq * 16 + k]; }
#pragma unroll
    for (int mi = 0; mi < 5; ++mi) *(LAS f32x4*)(red + (kq * 5 + mi) * 32 + c4) = acc[mi];
    __syncthreads();
    if (tid < 160) { const int mi = tid >> 5, jc = tid & 31; float s = 0.f;
#pragma unroll 16
        for (int g = 0; g < 64; ++g) s += red[(g * 5 + mi) * 32 + jc];
        out[(size_t)mi * ldo + c0 + jc] = s + (bias ? bias[c0 + jc] : 0.f); }
    __syncthreads();
}

__device__ __forceinline__ int lane_id_asm() { int r; asm volatile("v_mbcnt_lo_u32_b32 %0, -1, 0\n\tv_mbcnt_hi_u32_b32 %0, -1, %0" : "=v"(r)); return r; }
typedef __attribute__((address_space(4))) const Args* ArgsP;
#define PHASE_PTRS ArgsP a = ap; asm volatile("" : "+s"(a)); unsigned char* const ws = a->ws; float* const out = a->out; (void)ws; (void)out; \
    int tid = wave_s * 64 + lane_id_asm(); asm volatile("" : "+v"(tid)); const int lane = tid & 63, wave = __builtin_amdgcn_readfirstlane(tid >> 6); const int gw = bid * NWAVES + wave, NGW = G * NWAVES; (void)lane; (void)gw; (void)NGW;
#define x_prompt (a->in[0])
#define x_sample (a->in[1])
#define cache_na_k (a->in[2])
#define cache_na_v (a->in[3])
#define cache_ckv (a->in[4])
#define cache_kpe (a->in[5])
#define cache_swa_k (a->in[6])
#define cache_swa_v (a->in[7])
#define cond_in (a->in[8])
#define c_ctx (a->in[9])
#define norm1 (a->in[10])
#define norm2 (a->in[11])
#define w_ada (a->in[12])
#define b_ada (a->in[13])
#define w_in (a->in[14])
#define w_out (a->in[15])
#define na_q_norm (a->in[16])
#define na_k_norm (a->in[17])
#define na_rpb (a->in[18])
#define pool_w (a->in[19])
#define pool_scale (a->in[20])
#define mla_q_a_norm (a->in[21])
#define mla_w_uq (a->in[22])
#define mla_kv_norm (a->in[23])
#define mla_w_ukv (a->in[24])
#define mla_q_norm (a->in[25])
#define mla_k_norm (a->in[26])
#define swa_q_norm (a->in[27])
#define swa_k_norm (a->in[28])
#define swa_sink (a->in[29])
#define mlp_w1 (a->in[30])
#define mlp_w2 (a->in[31])
#define TAB ((float*)(ws + WS_TAB))
#define MOD ((float*)(ws + WS_MOD))
#define BA ((float*)(ws + WS_BA))
#define BD ((float*)(ws + WS_BD))
#define PARTA ((float*)(ws + WS_PARTA))
#define PARTD ((float*)(ws + WS_PARTD))
#define WUQ ((bf16*)(ws + WS_WUQ))
#define WUKV ((bf16*)(ws + WS_WUKV))
#define WPOOL ((bf16*)(ws + WS_WPOOL))
#define WIN ((bf16*)(ws + WS_WIN))
#define WOUT ((bf16*)(ws + WS_WOUT))
#define W1B ((bf16*)(ws + WS_W1))
#define W2B ((bf16*)(ws + WS_W2))
#define CKNA ((bf16*)(ws + WS_CKNA))
#define CVNA ((bf16*)(ws + WS_CVNA))
#define CKS ((bf16*)(ws + WS_CKS))
#define CVS ((bf16*)(ws + WS_CVS))
#define CKM ((bf16*)(ws + WS_CKM))
#define CVM ((bf16*)(ws + WS_CVM))
#define XB ((float*)(ws + WS_X))
#define XS ((bf16*)(ws + WS_XS))
#define MIX ((bf16*)(ws + WS_MIX))
#define PB ((bf16*)(ws + WS_P))
#define ZB ((bf16*)(ws + WS_Z))
#define QNA ((bf16*)(ws + WS_QNA))
#define KNA ((bf16*)(ws + WS_KNA))
#define VNA ((bf16*)(ws + WS_VNA))
#define QM ((bf16*)(ws + WS_QM))
#define KM ((bf16*)(ws + WS_KM))
#define VM ((bf16*)(ws + WS_VM))
#define QS ((bf16*)(ws + WS_QS))
#define KS ((bf16*)(ws + WS_KS))
#define VS ((bf16*)(ws + WS_VS))
#define ROPES ((const float*)(ws + WS_TAB))
#define ROPEM ((const float*)(ws + WS_TAB) + 2048)
__global__ void __launch_bounds__(NTHR, 2) fwd_megakernel(Args args) {
    extern __shared__ __attribute__((aligned(16))) unsigned char lds_raw[];
    LAS unsigned char* lds = (LAS unsigned char*)lds_raw;
    cg::grid_group grid = cg::this_grid();
    const int wave_s = __builtin_amdgcn_readfirstlane((int)threadIdx.x >> 6);
    const int tid0 = threadIdx.x;
    const int G = gridDim.x, bid = blockIdx.x;
    ArgsP ap = (ArgsP)__builtin_amdgcn_kernarg_segment_ptr();

    for (int u = tid0; u < (LDS_BYTES - LDSCTL_OFF) / 4; u += NTHR) ((LAS unsigned*)(lds + LDSCTL_OFF))[u] = 0u;
    __syncthreads();
    { PHASE_PTRS (void)xcd_barrier_post((unsigned*)(ws + WS_CTL) + 1024, (volatile LAS unsigned*)(lds + LDSCTL_OFF + 64)); }
#define GRID_BAR() do { ArgsP a_ = ap; asm volatile("" : "+s"(a_)); XcdBarrier b_; b_.bar = (unsigned*)(a_->ws + WS_CTL) + 1024; b_.x = xb_xcc_id(); asm volatile("" : "+s"(b_.x)); \
        b_.st = (volatile LAS unsigned*)(lds + LDSCTL_OFF + 64); xcd_barrier(b_); } while (0)


    {
        PHASE_PTRS
        LAS float* vec = (LAS float*)lds; LAS float* red = (LAS float*)(lds + 20480);
        for (int i = tid; i < 5 * 1024; i += NTHR) { const int mi = i >> 10, k = i & 1023; const float c = (mi == 0) ? c_ctx[k] : cond_in[(mi - 1) * 1024 + k]; vec[i] = c / (1.0f + __expf(-c)); }
        __syncthreads();
        for (int it = bid; it < NL * 192; it += G) { const int l = it / 192, cb = it % 192;
            gemv5_item(w_ada + (size_t)l * 1024 * 6144, 6144, cb * 32, vec, red, MOD + (size_t)l * 5 * 6144, 6144, b_ada + (size_t)l * 6144, tid); }
        __syncthreads();
        if (bid == 0) {
            for (int i = tid; i < 1024; i += NTHR) { const int pos = i >> 4, f = i & 15; const float fr = exp2f(-(float)f * (1.0f / 16.0f) * 13.287712379549449f); const float a = (float)pos * fr;
                TAB[i] = cosf(a); TAB[1024 + i] = sinf(a); }
            for (int i = tid; i < 512; i += NTHR) { const int pos = i >> 3, f = i & 7; const float fr = exp2f(-(float)f * (1.0f / 8.0f) * 13.287712379549449f); const float a = (float)pos * fr;
                TAB[2048 + i] = cosf(a); TAB[2048 + 512 + i] = sinf(a); }
        }
        LAS float* scr = (LAS float*)(lds + 61440 + wave * 8704);
        constexpr int I_IN = 16 * 61, I_OUT = 16 * 32, I_1 = 16 * 128, I_2 = 64 * 32, I_UQ = 4 * 12, I_UKV = 2 * 16, I_PW = 4 * 2;
        constexpr int I_L = I_IN + I_OUT + I_1 + I_2 + I_UQ + I_UKV + I_PW;
        for (int it = gw; it < NL * I_L; it += NGW) {
            const int l = it / I_L; int r = it % I_L;
            if (r < I_IN) { transpose_item(w_in + (size_t)l * 1024 * 1952, 1024, 1952, WIN + (size_t)l * 2048 * 1024, 0, scr, r, lane); continue; } r -= I_IN;
            if (r < I_OUT) { transpose_item(w_out + (size_t)l * 1024 * 1024, 1024, 1024, WOUT + (size_t)l * 1024 * 1024, 0, scr, r, lane); continue; } r -= I_OUT;
            if (r < I_1) { transpose_item(mlp_w1 + (size_t)l * 1024 * 4096, 1024, 4096, W1B + (size_t)l * 4096 * 1024, 0, scr, r, lane); continue; } r -= I_1;
            if (r < I_2) { transpose_item(mlp_w2 + (size_t)l * 4096 * 1024, 4096, 1024, W2B + (size_t)l * 1024 * 4096, 0, scr, r, lane); continue; } r -= I_2;
            if (r < I_UQ) { transpose_item(mla_w_uq + (size_t)l * 256 * 384, 256, 384, WUQ + (size_t)l * 384 * 256, 0, scr, r, lane); continue; } r -= I_UQ;
            if (r < I_UKV) { transpose_item(mla_w_ukv + (size_t)l * 128 * 512, 128, 512, WUKV + (size_t)l * 512 * 128, 0, scr, r, lane); continue; } r -= I_UKV;
            { const int g = r >> 1; transpose_item(pool_w + (size_t)(l * 4 + g) * 4096, 64, 64, WPOOL + (size_t)(l * 4 + g) * 4096, 0, scr, r & 1, lane); }
        }
        for (int i = bid * NTHR + tid; i < NL * 96 * 128; i += G * NTHR) { const int l = i / (96 * 128), r = i % (96 * 128); *(v4u*)(WIN + (size_t)l * 2048 * 1024 + (size_t)1952 * 1024 + (size_t)r * 8) = (v4u){0u, 0u, 0u, 0u}; }
    }
    GRID_BAR();
    if (gridDim.y > 60000u) grid.sync();

    {
        PHASE_PTRS
        LAS float* vec = (LAS float*)lds; LAS float* red = (LAS float*)(lds + 20480);
        for (int it = bid; it < NL * 189; it += G) { const int l = it / 189, r = it % 189; const bool isD = r >= 61; const int cb = isD ? r - 61 : r;
            __syncthreads();
            for (int i = tid; i < 5 * 1024; i += NTHR) { const int mi = i >> 10, k = i & 1023; vec[i] = MOD[(size_t)(l * 5 + mi) * 6144 + (isD ? 3072 : 0) + k]; }
            __syncthreads();
            if (isD) gemv5_item(mlp_w1 + (size_t)l * 1024 * 4096, 4096, cb * 32, vec, red, BD + (size_t)l * 5 * 4096, 4096, nullptr, tid);
            else gemv5_item(w_in + (size_t)l * 1024 * 1952, 1952, cb * 32, vec, red, BA + (size_t)l * 5 * 2048, 2048, nullptr, tid);
        }
        for (int row = gw; row < MT; row += NGW) {
            const float* xr = (row < M_CTX) ? x_prompt + (size_t)row * 1024 : x_sample + (size_t)(row - M_CTX) * 1024; const int mi = (row < M_CTX) ? 0 : 1 + ((row - M_CTX) >> 11);
            const float* scp = MOD + (size_t)mi * 6144 + 1024; float ss = 0.f;
#pragma unroll
            for (int j = 0; j < 4; ++j) { const int c = 4 * lane + 256 * j; const f32x4 v = *(const f32x4*)(xr + c); ss += (v[0] * v[0] + v[1] * v[1]) + (v[2] * v[2] + v[3] * v[3]);
                const f32x4 g = *(const f32x4*)(norm1 + c), s = *(const f32x4*)(scp + c); const f32x4 o = v * g * (s + 1.0f);
                typedef unsigned u32x2v __attribute__((ext_vector_type(2))); u32x2v w; w.x = cvtpk(o[0], o[1]); w.y = cvtpk(o[2], o[3]); *(u32x2v*)(XS + (size_t)row * 1024 + c) = w; }
            ss = wave_sum(ss);
            if (lane < 16) PARTA[(size_t)row * 16 + lane] = (lane == 0) ? ss : 0.f;
        }
    }
    {
        PHASE_PTRS
        for (int it = gw; it < 256 * 10; it += NGW) {
            int lane = tid & 63; asm volatile("" : "+v"(lane));
            const int sub = it % 10, u = it / 10; const int l = u >> 6, b = (u >> 4) & 3, tile = u & 15;
            const size_t lb = (size_t)(l * 4 + b);
            const size_t crow0 = ((size_t)b * 4 + l) * 512;
            if (sub < 2) {
                const int h = 2 * sub + (lane >> 5);
                head_norm_task<true, false>(cache_na_k, 256, (int)crow0 + tile * 32, h * 64, nullptr, true, 1.0f, nullptr, 0, 0, CKNA + (lb * 4 + h) * 16 * 2048, tile, nullptr, lane);
            } else if (sub < 4) {
                for (int hh = 0; hh < 2; ++hh) { const int h = 2 * (sub - 2) + hh; vtrans_task<true>(cache_na_v, 256, (int)crow0 + tile * 32, h * 64, CVNA + (lb * 4 + h) * 16 * 2048, tile, nullptr, 0, lane); }
            } else if (sub == 4) {
                const int h = lane >> 5;
                head_norm_task<true, false>(cache_swa_k, 128, (int)crow0 + tile * 32, h * 64, nullptr, true, 1.0f, nullptr, 0, 0, CKS + (lb * 2 + h) * 16 * 2048, tile, nullptr, lane);
            } else if (sub == 5) {
                for (int h = 0; h < 2; ++h) vtrans_task<true>(cache_swa_v, 128, (int)crow0 + tile * 32, h * 64, CVS + (lb * 2 + h) * 16 * 2048, tile, nullptr, 0, lane);
            } else {
                const int h = sub - 6;
                mla_kv_task<true, false>(cache_ckv, 128, 0, cache_kpe, 32, 0, (int)crow0 + tile * 32, nullptr, WUKV + (size_t)l * 512 * 128, nullptr, h, mla_k_norm + l * 96, nullptr, 0,
                                         CKM + (lb * 4 + h) * 16 * 3072, CVM + (lb * 4 + h) * 16 * 2048, tile, nullptr, nullptr, lane);
            }
        }
    }
    GRID_BAR();

    int mla_seq = 0;
    for (int l = 0; l < NL; ++l) {
        for (int rep_ = 0; rep_ < REP_A; ++rep_) {
        {
            PHASE_PTRS
            pg8::Gemm g{XS, WIN + (size_t)l * 2048 * 1024, MT, NPROJP, DM}; pg8::StaticOrder S; S.init(MT, NPROJP, G, bid, 192);
            pg8::EpiScaleBias<0, true> E{PB, NPROJP, BA + (size_t)l * 5 * 2048, 2048, PARTA};
            pg8::gemm_phase<pg8::EpiScaleBias<0, true>, pg8::StaticOrder, true, true, 3>(lds, g, S, E, tid);
        }
        GRID_BAR();
        }
        for (int rep_ = 0; rep_ < REP_A2; ++rep_) {
        {
            PHASE_PTRS
            {
                const int head = bid & 3;
                const bf16* wq = WUQ + (size_t)l * 384 * 256; const bf16* wkv = WUKV + (size_t)l * 512 * 128;
                LAS bf16x8* lq = (LAS bf16x8*)lds; LAS bf16x8* lkv = (LAS bf16x8*)(lds + 49152);
                for (int p = tid; p < 48 * 64; p += NTHR) { const int f = p >> 6, ln = p & 63, ft = f >> 4, kc = f & 15;
                    const v4u w = *(const v4u*)(wq + (size_t)(head * 96 + 32 * ft + swz(ln & 31)) * 256 + 16 * kc + 8 * (ln >> 5));
                    const float* gp = mla_q_a_norm + l * 256 + 16 * kc + 8 * (ln >> 5); const f32x4 g0 = *(const f32x4*)gp, g1 = *(const f32x4*)(gp + 4);
                    lq[p] = pack8(bflo(w.x) * g0[0], bfhi(w.x) * g0[1], bflo(w.y) * g0[2], bfhi(w.y) * g0[3], bflo(w.z) * g1[0], bfhi(w.z) * g1[1], bflo(w.w) * g1[2], bfhi(w.w) * g1[3]); }
                LAS float* ltab = (LAS float*)(lds + 81920);
                for (int p = tid; p < 1344; p += NTHR) ltab[p] = (p < 96) ? mla_q_norm[l * 96 + p] : (p < 192) ? mla_k_norm[l * 96 + (p - 96)] : (p < 320) ? mla_kv_norm[l * 128 + (p - 192)] : ROPEM[p - 320];
                for (int p = tid; p < 32 * 64; p += NTHR) { const int f = p >> 6, ln = p & 63, part = f >> 4, t2 = (f >> 3) & 1, kc = f & 7; const int i5 = ln & 31;
                    const int wrow = head * 128 + (part ? 64 + 32 * t2 + i5 : 32 * t2 + swz(i5));
                    lkv[p] = *(const bf16x8*)(wkv + (size_t)wrow * 128 + 16 * kc + 8 * (ln >> 5)); }
                __syncthreads();
                if (wave < 6) {
                    for (int tg = bid >> 2; tg < 64; tg += (G >> 2)) {
                        int lane = tid & 63; asm volatile("" : "+v"(lane));
                        const int gt = tg * 6 + wave; const int row0 = gt * 32; const bool lat = gt >= GT_LAT0; const TokInfo t0i = tok_info(row0);
                        const size_t crow = ((size_t)(t0i.b * 4 + l)) * 256 + t0i.t;
                        mla_q_task(PB, row0, mla_q_a_norm + l * 256, wq, lq, head, (const float*)ltab, (const float*)(ltab + 320), QM + (size_t)head * NGT * 3072, gt, lane);
                        mla_kv_task<false, true>(PB, NPROJP, C_CKV, PB, NPROJP, C_KPE, row0, (const float*)(ltab + 192), wkv, lkv, head, (const float*)(ltab + 96), lat ? (const float*)(ltab + 320) : nullptr, t0i.t,
                                                 KM + (size_t)head * NGT * 3072, VM + (size_t)head * NGT * 2048, gt, (!lat && head == 0) ? out + O_CKV + crow * 128 : nullptr, (!lat && head == 0) ? out + O_KPE + crow * 32 : nullptr, lane);
                    }
                }
            }
            for (int it = gw; it < NGT * 6; it += NGW) {
                int lane = tid & 63; asm volatile("" : "+v"(lane));
                const int gt = it / 6, sub = it % 6; const int row0 = gt * 32; const bool lat = gt >= GT_LAT0;
                const int tok = lane & 31; const TokInfo ti = tok_info(row0 + tok);
                const TokInfo t0i = tok_info(row0);
                const size_t crow = ((size_t)(t0i.b * 4 + l)) * 256 + t0i.t;
                const int hs = lane >> 5;
                if (sub < 2) { const int h = 2 * sub + hs; head_norm_task<false, true>(PB, NPROJP, row0, C_NAK + h * 64, na_k_norm + l * 64, true, 1.0f, nullptr, 0, 0, KNA + (size_t)h * NGT * 2048, gt,
                                                                                       lat ? nullptr : out + O_NAK + (crow + tok) * 256 + h * 64, lane); }
                else if (sub == 2) { const int h = hs; head_norm_task<false, true>(PB, NPROJP, row0, C_SK + h * 64, swa_k_norm + l * 64, true, 1.0f, lat ? ROPES : nullptr, ti.t >> 6, ti.t & 63, KS + (size_t)h * NGT * 2048, gt,
                                                                                   lat ? nullptr : out + O_SK + (crow + tok) * 128 + h * 64, lane); }
                else if (sub < 5) {
                    for (int hh = 0; hh < 2; ++hh) { const int h = 2 * (sub - 3) + hh; vtrans_task<false>(PB, NPROJP, row0, C_NAV + h * 64, VNA + (size_t)h * NGT * 2048, gt, lat ? nullptr : out + O_NAV + crow * 256 + h * 64, 256, lane); }
                } else {
                    for (int h = 0; h < 2; ++h) vtrans_task<false>(PB, NPROJP, row0, C_SV + h * 64, VS + (size_t)h * NGT * 2048, gt, lat ? nullptr : out + O_SV + crow * 128 + h * 64, 128, lane);
                }
            }
        }
        GRID_BAR();
        }
        for (int rep_ = 0; rep_ < REP_B; ++rep_) {
        {
            PHASE_PTRS
            LAS float* rpb = (LAS float*)lds;
            const int vb = (G % 8 == 0) ? (bid % 8) * (G / 8) + bid / 8 : bid;
            __syncthreads();
            for (int i = tid; i < 64 + 4 * 465 + 64; i += NTHR) rpb[i] = (i >= 64 && i < 64 + 4 * 465) ? na_rpb[(size_t)l * 4 * 465 + (i - 64)] * LOG2E : 0.f;
            __syncthreads();
            if (wave < 4) {
                LAS float* xm = (LAS float*)(lds + 8192);
                LAS float* xo = (LAS float*)(lds + 16384);
                volatile LAS unsigned* cnt = (volatile LAS unsigned*)(lds + LDSCTL_OFF + 256);
                for (int rep2_ = 0; rep2_ < REP_MLA; ++rep2_)
                for (int it = vb; it < 512; it += G, ++mla_seq) {
                    const int b = it >> 7, h = (it >> 5) & 3, qb = it & 31; const int gt0 = GT_LAT0 + b * 64, gtq = gt0 + 2 * qb;
                    bf16x8 qf[2][6]; load_q<6, 2>(qf, QM + (size_t)h * NGT * 3072, gtq, lane);
                    ATTN_INIT(2)
                    const int k0 = 20 * wave, k1 = k0 + 20;
                    if (k0 < 64) attn_range<6, 0, 2>(m, lsum, o, qf, KM + (size_t)h * NGT * 3072, VM + (size_t)h * NGT * 2048, gt0 + k0, gt0 + (k1 < 64 ? k1 : 64), lane, 0, 0, rpb);
                    if (k1 > 64) { const size_t cb = ((size_t)(l * 4 + b) * 4 + h) * 16;
                        attn_range<6, 0, 2>(m, lsum, o, qf, CKM + cb * 3072, CVM + cb * 2048, (k0 > 64 ? k0 : 64) - 64, k1 - 64, lane, 0, 0, rpb); }
                    const int buf = mla_seq & 1;
                    LAS float* mym = xm + (buf * 4 + wave) * 256 + lane;
                    mym[0] = m[0]; mym[64] = m[1]; mym[128] = lsum[0] + __shfl_xor(lsum[0], 32); mym[192] = lsum[1] + __shfl_xor(lsum[1], 32);
                    f32x16 mine = o[0][0];
#pragma unroll
                    for (int s = 0; s < 4; ++s) {
                        if (s == wave) { mine = o[s >> 1][s & 1]; }
                        else { LAS float* dst = xo + (size_t)(((buf * 4 + wave) * 3 + (s - (s > wave ? 1 : 0))) * 1024) + lane;
#pragma unroll
                            for (int r = 0; r < 16; ++r) dst[r * 64] = o[s >> 1][s & 1][r]; }
                    }
                    asm volatile("s_waitcnt lgkmcnt(0)" ::: "memory");
                    __builtin_amdgcn_fence(__ATOMIC_RELEASE, "workgroup");
                    if (lane == 0) __hip_atomic_fetch_add((LAS unsigned*)cnt, 1u, __ATOMIC_RELAXED, __HIP_MEMORY_SCOPE_WORKGROUP);
                    { const unsigned target = 4u * (unsigned)(mla_seq + 1); while (*cnt < target) __builtin_amdgcn_s_sleep(1); }
                    __builtin_amdgcn_fence(__ATOMIC_ACQUIRE, "workgroup");
                    asm volatile("" ::: "memory");
                    const int jq = wave >> 1, dvt = wave & 1;
                    float mw[4], lw[4]; float M = NEGBIG;
#pragma unroll
                    for (int w = 0; w < 4; ++w) { const LAS float* pm = xm + (buf * 4 + w) * 256 + lane; mw[w] = pm[jq * 64]; lw[w] = pm[128 + jq * 64]; M = fmaxf(M, mw[w]); }
                    float L = 0.f; f32x16 acc = {0.f, 0.f, 0.f, 0.f, 0.f, 0.f, 0.f, 0.f, 0.f, 0.f, 0.f, 0.f, 0.f, 0.f, 0.f, 0.f};
#pragma unroll
                    for (int w = 0; w < 4; ++w) { const float aw = __builtin_amdgcn_exp2f(mw[w] - M); L += aw * lw[w];
                        if (w == wave) {
#pragma unroll
                            for (int r = 0; r < 16; ++r) acc[r] += aw * mine[r];
                        } else { const LAS float* ps = xo + (size_t)(((buf * 4 + w) * 3 + (wave - (wave > w ? 1 : 0))) * 1024) + lane;
#pragma unroll
                            for (int r = 0; r < 16; ++r) acc[r] += aw * ps[r * 64]; } }
                    const float inv = 1.0f / L; const int hh = lane >> 5;
                    bf16* mrow = MIX + (size_t)((gtq + jq) * 32 + (lane & 31)) * 1024 + 512 + h * 64 + 32 * dvt + 4 * hh;
                    typedef unsigned u32x2v __attribute__((ext_vector_type(2)));
#pragma unroll
                    for (int g = 0; g < 4; ++g) { u32x2v w0; w0.x = cvtpk(acc[4 * g] * inv, acc[4 * g + 1] * inv); w0.y = cvtpk(acc[4 * g + 2] * inv, acc[4 * g + 3] * inv); *(u32x2v*)(mrow + 8 * g) = w0; }
                }
                for (int it = vb * 4 + wave; it < 1536; it += G * 4) {
                    int lane = tid & 63; asm volatile("" : "+v"(lane));
                    const int gt = it >> 2, g = it & 3;
                    pool_task(PB, WPOOL + (size_t)(l * 4 + g) * 4096, pool_scale + l * 256 + g * 64, MIX, gt, g, lane);
                }
            }
            {
                const int it0_ = (wave >= 4) ? vb * 4 + (wave - 4) : 1024 + vb * 4 + wave, it1_ = (wave >= 4) ? 1024 : 1792;
                for (int it = it0_; it < it1_; it += G * 4) {
                    int lane = tid & 63; asm volatile("" : "+v"(lane));
                    if (it < 512) {
                        const int b = it >> 7, h = (it >> 5) & 3, qr = it & 31; const int gt0 = GT_LAT0 + b * 64, gtq = gt0 + qr * 2;
                        bf16x8 qf[2][4]; make_q64(qf, PB, gtq, C_NAQ + h * 64, na_q_norm + l * 64, 0.125f * LOG2E, nullptr, lane);
                        ATTN_INIT(2)
                        int kr0 = qr - 4; kr0 = kr0 < 0 ? 0 : (kr0 > 24 ? 24 : kr0);
                        attn_range<4, 1, 2>(m, lsum, o, qf, KNA + (size_t)h * NGT * 2048, VNA + (size_t)h * NGT * 2048, gt0 + kr0 * 2, gt0 + kr0 * 2 + 16, lane, gt0, qr * 64 + (lane & 31), rpb + 64 + h * 465);
                        const size_t cb = ((size_t)(l * 4 + b) * 4 + h) * 16;
                        attn_range<4, 0, 2>(m, lsum, o, qf, CKNA + cb * 2048, CVNA + cb * 2048, 0, 16, lane, 0, 0, rpb);
#pragma unroll
                        for (int j = 0; j < 2; ++j) attn_store(m[j], lsum[j], o[j][0], o[j][1], false, 0.f, MIX + (size_t)((gtq + j) * 32 + (lane & 31)) * 1024 + 0 + h * 64, lane);
                    } else if (it < 1024) {
                        const int i2 = it - 512; const int b = i2 >> 7, h = (i2 >> 5) & 3, qb = i2 & 31; const int gt0 = GT_LAT0 + b * 64, gtq = gt0 + 2 * qb; const int kvh = h >> 1;
                        bf16x8 qf[2][4]; make_q64(qf, PB, gtq, C_SQ + h * 64, swa_q_norm + l * 64, 0.125f * LOG2E, ROPES, lane);
                        ATTN_INIT(2)
                        const int ta = 2 * qb - 4 < 0 ? 0 : 2 * qb - 4, tb = 2 * qb + 6 > 64 ? 64 : 2 * qb + 6;
                        attn_range<4, 2, 2>(m, lsum, o, qf, KS + (size_t)kvh * NGT * 2048, VS + (size_t)kvh * NGT * 2048, gt0 + ta, gt0 + tb, lane, gt0, qb * 64 + (lane & 31), rpb);
                        const size_t cb = ((size_t)(l * 4 + b) * 2 + kvh) * 16;
                        attn_range<4, 0, 2>(m, lsum, o, qf, CKS + cb * 2048, CVS + cb * 2048, 0, 16, lane, 0, 0, rpb);
                        const float sk = swa_sink[l * 4 + h];
#pragma unroll
                        for (int j = 0; j < 2; ++j) attn_store(m[j], lsum[j], o[j][0], o[j][1], true, sk, MIX + (size_t)((gtq + j) * 32 + (lane & 31)) * 1024 + 768 + h * 64, lane);
                    } else if (it < 1792) {
                        const int j3 = it - 1024; const int kind = j3 >> 8, b = (j3 >> 4) & 15, h = (j3 >> 2) & 3, qb = j3 & 3; const int gt0 = b * 8, gtq = gt0 + 2 * qb;
                        ATTN_INIT(2)
                        if (kind == 1) {
                            bf16x8 qf[2][6]; load_q<6, 2>(qf, QM + (size_t)h * NGT * 3072, gtq, lane);
                            attn_range<6, 0, 2>(m, lsum, o, qf, KM + (size_t)h * NGT * 3072, VM + (size_t)h * NGT * 2048, gt0, gt0 + 8, lane, 0, 0, rpb);
#pragma unroll
                            for (int j = 0; j < 2; ++j) attn_store(m[j], lsum[j], o[j][0], o[j][1], false, 0.f, MIX + (size_t)((gtq + j) * 32 + (lane & 31)) * 1024 + 512 + h * 64, lane);
                        } else if (kind == 0) {
                            bf16x8 qf[2][4]; make_q64(qf, PB, gtq, C_NAQ + h * 64, na_q_norm + l * 64, 0.125f * LOG2E, nullptr, lane);
                            attn_range<4, 0, 2>(m, lsum, o, qf, KNA + (size_t)h * NGT * 2048, VNA + (size_t)h * NGT * 2048, gt0, gt0 + 8, lane, 0, 0, rpb);
#pragma unroll
                            for (int j = 0; j < 2; ++j) attn_store(m[j], lsum[j], o[j][0], o[j][1], false, 0.f, MIX + (size_t)((gtq + j) * 32 + (lane & 31)) * 1024 + 0 + h * 64, lane);
                        } else {
                            const int kvh = h >> 1;
                            bf16x8 qf[2][4]; make_q64(qf, PB, gtq, C_SQ + h * 64, swa_q_norm + l * 64, 0.125f * LOG2E, nullptr, lane);
                            attn_range<4, 0, 2>(m, lsum, o, qf, KS + (size_t)kvh * NGT * 2048, VS + (size_t)kvh * NGT * 2048, gt0, gt0 + 8, lane, 0, 0, rpb);
                            const float sk = swa_sink[l * 4 + h];
#pragma unroll
                            for (int j = 0; j < 2; ++j) attn_store(m[j], lsum[j], o[j][0], o[j][1], true, sk, MIX + (size_t)((gtq + j) * 32 + (lane & 31)) * 1024 + 768 + h * 64, lane);
                        }
                    }
                }
            }
        }
        GRID_BAR();
        }
        {
            PHASE_PTRS
            pg8::Gemm g{MIX, WOUT + (size_t)l * 1024 * 1024, MT, DM, DM}; pg8::StaticOrder S; S.init(MT, DM, G, bid, 192);
            pg8::EpiResid E{l == 0 ? x_prompt : XB, l == 0 ? x_sample : XB + (size_t)M_CTX * 1024, XB, XS, MOD + (size_t)l * 5 * 6144 + 2048, norm2 + l * 1024, MOD + (size_t)l * 5 * 6144 + 4096, PARTD};
            pg8::gemm_phase<pg8::EpiResid, pg8::StaticOrder, true, true, 3>(lds, g, S, E, tid);
        }
        GRID_BAR();
        for (int rep_ = 0; rep_ < REP_D; ++rep_) {
        {
            PHASE_PTRS
            pg8::Gemm g{XS, W1B + (size_t)l * 4096 * 1024, MT, DFF, DM}; pg8::StaticOrder S; S.init(MT, DFF, G, bid);
            pg8::EpiScaleBias<1> E{ZB, DFF, BD + (size_t)l * 5 * 4096, 4096, PARTD};
            pg8::gemm_phase<pg8::EpiScaleBias<1>, pg8::StaticOrder, true, true>(lds, g, S, E, tid);
        }
        GRID_BAR();
        }
        {
            PHASE_PTRS
            const bool last = (l == NL - 1);
            pg8::Gemm g{ZB, W2B + (size_t)l * 1024 * 4096, MT, DM, DFF}; pg8::StaticOrder S; S.init(MT, DM, G, bid, 192);
            pg8::EpiResid E{XB, XB + (size_t)M_CTX * 1024, last ? out : XB, last ? nullptr : XS, MOD + (size_t)l * 5 * 6144 + 5120, norm1 + (last ? 0 : (l + 1) * 1024), MOD + (size_t)(last ? 0 : (l + 1)) * 5 * 6144 + 1024, PARTA};
            pg8::gemm_phase<pg8::EpiResid, pg8::StaticOrder, true, true, 3>(lds, g, S, E, tid);
        }
        if (l + 1 < NL) GRID_BAR();
    }
}
}

extern "C" void kernel_launch(void* const* d_in, const int* in_sizes, int n_in, void* d_out, int out_size, void* d_ws, size_t ws_size, hipStream_t stream) {
    static int grid = 0;
    if (grid == 0) {
        if (n_in != 32 || ws_size < mk::WS_END) { fprintf(stderr, "kernel_launch: unexpected n_in %d / ws_size %zu\n", n_in, ws_size); grid = -1; return; }
        int dev = 0, cus = 0, per_cu = 0;
        hipGetDevice(&dev); hipDeviceGetAttribute(&cus, hipDeviceAttributeMultiprocessorCount, dev);
        if (hipFuncSetAttribute((const void*)mk::fwd_megakernel, hipFuncAttributeMaxDynamicSharedMemorySize, mk::LDS_BYTES) != hipSuccess) { fprintf(stderr, "kernel_launch: hipFuncSetAttribute failed\n"); grid = -1; return; }
        if (hipOccupancyMaxActiveBlocksPerMultiprocessor(&per_cu, (const void*)mk::fwd_megakernel, mk::NTHR, mk::LDS_BYTES) != hipSuccess || per_cu < 1) { fprintf(stderr, "kernel_launch: occupancy query failed (%d)\n", per_cu); (void)hipGetLastError(); per_cu = 1; }
        grid = cus * per_cu;
        fprintf(stderr, "kernel_launch: grid %d (cus %d x %d)\n", grid, cus, per_cu);
    }
    if (grid < 0) return;
    (void)hipMemsetAsync((char*)d_ws + mk::WS_CTL, 0, mk::CTL_ZERO_BYTES, stream);
    mk::Args a{};
    for (int i = 0; i < 32; ++i) a.in[i] = (const float*)d_in[i];
    a.out = (float*)d_out; a.ws = (unsigned char*)d_ws;
    void* params[] = {&a};
    hipError_t e = hipLaunchCooperativeKernel((const void*)mk::fwd_megakernel, dim3(grid), dim3(mk::NTHR), params, mk::LDS_BYTES, stream);
    if (e != hipSuccess) fprintf(stderr, "kernel_launch: cooperative launch failed: %s (grid %d)\n", hipGetErrorString(e), grid);
}
```

```cpp
#include <hip/hip_runtime.h>
#include <hip/hip_cooperative_groups.h>
#include <cstdio>
#include <cstdint>
namespace cg = cooperative_groups;
#ifndef MK_XCD_BARRIER
#define MK_XCD_BARRIER 0
#endif
namespace pg8 {
#define PG8_LAS __attribute__((address_space(3)))
typedef unsigned short bf16_t;
typedef short bf16x8 __attribute__((ext_vector_type(8)));
typedef float f32x4 __attribute__((ext_vector_type(4)));
typedef unsigned u32x4 __attribute__((ext_vector_type(4)));
constexpr int BM = 256, BK = 64, HALF = 128, HTB = HALF * BK * 2  , STAGE_BYTES = 8 * HTB, NXCD = 8, WGM = 2;

__host__ __device__ __forceinline__ int lds_byte(int r, int c) { const int st = (r >> 4) * 2 + (c >> 5), rr = r & 15, cc = c & 31, ob = rr * 64 + cc * 2; return st * 1024 + (ob ^ (((ob >> 9) & 1) << 5)); }
__host__ __device__ __forceinline__ void stage_rc(int b, int& R, int& C) { const int st = b / 1024, sb = b % 1024, swz = sb ^ (((sb >> 9) & 1) << 5); R = (st >> 1) * 16 + swz / 64; C = (st & 1) * 32 + (swz % 64) / 2; }
__host__ __device__ __forceinline__ int perm32(int rho) { const int n = rho >> 4, i = rho & 15; return 8 * (i >> 2) + 4 * n + (i & 3); }

struct Unit { int pm, pn; };
struct Gemm { const bf16_t* A; const bf16_t* Bt; int M, N, K; };

struct StaticOrder {
    int nM, nN, nwg, G, c;
    __host__ __device__ void init(int M, int N, int G_, int c_, int bm = BM) { nM = M / bm; nN = N / BM; nwg = nM * nN; G = G_; c = c_; }
    __host__ __device__ bool next(int i, Unit& u) const {
        const long L = (long)i * G + c; if (L >= nwg) return false;
        int wgid = (int)L; { const int q = nwg / NXCD, r = nwg % NXCD, xcd = wgid % NXCD, off = wgid / NXCD; wgid = (xcd < r ? xcd * (q + 1) : r * (q + 1) + (xcd - r) * q) + off; }
        const int nig = WGM * nN, gid = wgid / nig, fm = gid * WGM, gsz = (nM - fm) < WGM ? (nM - fm) : WGM;
        u.pm = fm + ((wgid % nig) % gsz); u.pn = (wgid % nig) / gsz; return true;
    }
    __device__ __forceinline__ void a_ready(const Unit&) const {}
    __device__ __forceinline__ void done(const Unit&) const {}
};

__device__ __forceinline__ unsigned cvt_pk_bf16(float lo, float hi) { unsigned r; asm volatile("v_cvt_pk_bf16_f32 %0, %1, %2" : "=v"(r) : "v"(lo), "v"(hi)); return r; }
__device__ __forceinline__ int mod_index_row(int row) { return row < 4096 ? 0 : 1 + ((row - 4096) >> 11); }

template <int MT> __device__ __forceinline__ void rows_rstd(const float* part, int rowb, int fr, int fq, float (&rs)[2][MT]) {
    constexpr int HR = 32 * MT;
    f32x4 pv[2][MT];
#pragma unroll
    for (int ai = 0; ai < 2; ++ai)
#pragma unroll
        for (int m = 0; m < MT; ++m) pv[ai][m] = *(const f32x4*)(part + (size_t)(rowb + ai * HR + m * 16 + fr) * 16 + 4 * fq);
#pragma unroll
    for (int ai = 0; ai < 2; ++ai)
#pragma unroll
        for (int m = 0; m < MT; ++m) { float s = (pv[ai][m][0] + pv[ai][m][1]) + (pv[ai][m][2] + pv[ai][m][3]); s += __shfl_xor(s, 16); s += __shfl_xor(s, 32);
            rs[ai][m] = 1.0f / sqrtf(s * (1.0f / 1024.0f) + 1e-6f); }
}

template <int ACT, bool BLK = false> struct EpiScaleBias {
    static constexpr bool PERM = true, AFTER_DRAIN = false;
    bf16_t* O; int ldc; const float* bias; int ldb; const float* part;
    template <int MT>
    __device__ __forceinline__ void operator()(const f32x4 (&acc)[2][2][MT][2], const Unit& u, int wr, int wc, int fr, int fq) const {
        constexpr int HR = 32 * MT;
        asm volatile("" : "+v"(fr), "+v"(fq));
        const int rowb = u.pm * (2 * HR) + wr * (HR / 2); const int col0 = u.pn * BM + wc * 32 + 8 * fq;
        const int mi0 = mod_index_row(rowb), mi1 = mod_index_row(rowb + HR + (MT - 1) * 16);
        f32x4 bb[2][2];
#pragma unroll
        for (int bj = 0; bj < 2; ++bj) { const float* bp = bias + (size_t)mi0 * ldb + col0 + bj * HALF; bb[bj][0] = *(const f32x4*)bp; bb[bj][1] = *(const f32x4*)(bp + 4); }
        float rs[2][MT]; rows_rstd<MT>(part, rowb, fr, fq, rs);
#pragma unroll
        for (int ai = 0; ai < 2; ++ai)
#pragma unroll
            for (int m = 0; m < MT; ++m) { const int grow = rowb + ai * HR + m * 16; const int row = grow + fr; const float r1 = rs[ai][m];
                f32x4 c[2][2] = {{bb[0][0], bb[0][1]}, {bb[1][0], bb[1][1]}};
                if (mi0 != mi1) { const int mg = mod_index_row(grow); if (mg != mi0) {
#pragma unroll
                    for (int bj = 0; bj < 2; ++bj) { const float* bp = bias + (size_t)mg * ldb + col0 + bj * HALF; c[bj][0] = *(const f32x4*)bp; c[bj][1] = *(const f32x4*)(bp + 4); } } }
                bf16_t* rowp = BLK ? O + (((size_t)((row >> 5) * 256 + (col0 >> 3))) << 8) + ((row & 31) << 3) : O + (size_t)row * ldc + col0;
#pragma unroll
                for (int bj = 0; bj < 2; ++bj) { f32x4 v0 = acc[ai][bj][m][0] * r1 + c[bj][0], v1 = acc[ai][bj][m][1] * r1 + c[bj][1];
                    if (ACT == 1) {
#pragma unroll
                        for (int e = 0; e < 4; ++e) { const float a = fmaxf(v0[e], 0.f), b = fmaxf(v1[e], 0.f); v0[e] = a * a; v1[e] = b * b; } }
                    u32x4 w; w.x = cvt_pk_bf16(v0[0], v0[1]); w.y = cvt_pk_bf16(v0[2], v0[3]); w.z = cvt_pk_bf16(v1[0], v1[1]); w.w = cvt_pk_bf16(v1[2], v1[3]);
                    *(u32x4*)(rowp + (BLK ? bj * (HALF / 8) * 256 : bj * HALF)) = w; } }
    }
};

struct EpiResid {
    static constexpr bool PERM = false, AFTER_DRAIN = false;
    const float* xinA; const float* xinB;
    float* xout; bf16_t* xs; const float* gate; const float* normg; const float* sc; float* part;
    template <int MT>
    __device__ __forceinline__ void operator()(const f32x4 (&acc)[2][2][MT][2], const Unit& u, int wr, int wc, int fr, int fq) const {
        typedef unsigned u32x2v __attribute__((ext_vector_type(2)));
        constexpr int HR = 32 * MT;
        asm volatile("" : "+v"(fr), "+v"(fq));
        const int rowb = u.pm * (2 * HR) + wr * (HR / 2); const int col0 = u.pn * BM + wc * 32 + 4 * fq;
        const int mi0 = mod_index_row(rowb), mi1 = mod_index_row(rowb + HR + (MT - 1) * 16);
        f32x4 gv0[2][2], sv0[2][2];
#pragma unroll
        for (int bj = 0; bj < 2; ++bj)
#pragma unroll
            for (int n = 0; n < 2; ++n) { const int c = col0 + bj * HALF + n * 16; gv0[bj][n] = *(const f32x4*)(gate + (size_t)mi0 * 6144 + c);
                sv0[bj][n] = xs ? *(const f32x4*)(normg + c) * (*(const f32x4*)(sc + (size_t)mi0 * 6144 + c) + 1.0f) : (f32x4){0.f, 0.f, 0.f, 0.f}; }
        f32x4 xc[2][2], xn_[2][2];
        { const int row = rowb + fr; const float* xr = (row < 4096) ? xinA + (size_t)row * 1024 : xinB + (size_t)(row - 4096) * 1024;
#pragma unroll
          for (int bj = 0; bj < 2; ++bj)
#pragma unroll
              for (int n = 0; n < 2; ++n) xc[bj][n] = *(const f32x4*)(xr + col0 + bj * HALF + n * 16); }
#pragma unroll
        for (int ai = 0; ai < 2; ++ai)
#pragma unroll
            for (int m = 0; m < MT; ++m) { const int grow = rowb + ai * HR + m * 16; const int row = grow + fr;
                if (!(ai == 1 && m == MT - 1)) { const int nrow = rowb + (m == MT - 1 ? HR : ai * HR + (m + 1) * 16) + fr;
                    const float* xr = (nrow < 4096) ? xinA + (size_t)nrow * 1024 : xinB + (size_t)(nrow - 4096) * 1024;
#pragma unroll
                    for (int bj = 0; bj < 2; ++bj)
#pragma unroll
                        for (int n = 0; n < 2; ++n) xn_[bj][n] = *(const f32x4*)(xr + col0 + bj * HALF + n * 16); }
                f32x4 gv[2][2] = {{gv0[0][0], gv0[0][1]}, {gv0[1][0], gv0[1][1]}}, sv[2][2] = {{sv0[0][0], sv0[0][1]}, {sv0[1][0], sv0[1][1]}};
                if (mi0 != mi1) { const int mg = mod_index_row(grow); if (mg != mi0) {
#pragma unroll
                    for (int bj = 0; bj < 2; ++bj)
#pragma unroll
                        for (int n = 0; n < 2; ++n) { const int c = col0 + bj * HALF + n * 16; gv[bj][n] = *(const f32x4*)(gate + (size_t)mg * 6144 + c);
                            if (xs) sv[bj][n] = *(const f32x4*)(normg + c) * (*(const f32x4*)(sc + (size_t)mg * 6144 + c) + 1.0f); } } }
                float ss = 0.f;
#pragma unroll
                for (int bj = 0; bj < 2; ++bj)
#pragma unroll
                    for (int n = 0; n < 2; ++n) { const int c = col0 + bj * HALF + n * 16; const f32x4 xn = xc[bj][n] + gv[bj][n] * acc[ai][bj][m][n];
                        *(f32x4*)(xout + (size_t)row * 1024 + c) = xn; ss += (xn[0] * xn[0] + xn[1] * xn[1]) + (xn[2] * xn[2] + xn[3] * xn[3]);
                        if (xs) { const f32x4 o = xn * sv[bj][n]; u32x2v w; w.x = cvt_pk_bf16(o[0], o[1]); w.y = cvt_pk_bf16(o[2], o[3]); *(u32x2v*)(xs + (size_t)row * 1024 + c) = w; } }
                ss += __shfl_xor(ss, 16); ss += __shfl_xor(ss, 32);
                if (fq == 0) part[(size_t)row * 16 + u.pn * 4 + wc] = ss;
#pragma unroll
                for (int bj = 0; bj < 2; ++bj)
#pragma unroll
                    for (int n = 0; n < 2; ++n) xc[bj][n] = xn_[bj][n]; }
    }
};

template <class Epi, class Sched, bool ALIGN_EPI = false, bool SP2 = false, int MT = 4>
__device__ __forceinline__ void gemm_phase(PG8_LAS unsigned char* lds, const Gemm g, const Sched& S, const Epi& E, int tid_in) {
    int tid = tid_in; asm volatile("" : "+v"(tid));
    const int wid = __builtin_amdgcn_readfirstlane(tid >> 6), lane = tid & 63, wr = wid >> 2, wc = wid & 3, fr = lane & 15, fq = lane >> 4;
    const int K = g.K, nt = K / BK;
    unsigned voffA[2], voffB[2];
#pragma unroll
    for (int i = 0; i < 2; ++i) { int R, C; stage_rc(tid * 16 + i * 8192, R, C); const int Rb = Epi::PERM ? ((R & ~31) + perm32(R & 31)) : R;
        voffA[i] = (unsigned)(R * K + C) * 2u; voffB[i] = (unsigned)(Rb * K + C) * 2u; }
    const size_t kstep = (size_t)(BK * 2);
    static_assert(MT == 4 || (MT == 3 && SP2), "the 192-row tile is only wired into the two-super-phase loop");
    constexpr int HR = 32 * MT;
    const size_t hstepA = (size_t)HR * K * 2, hstepB = (size_t)HALF * K * 2;
    const size_t tstepA = 2 * hstepA, tstepB = 2 * hstepB;
    const unsigned ldsw = (unsigned)wid * 1024u;
    const int aoff = lds_byte(wr * (HR / 2) + fr, fq * 8), boff = lds_byte(wc * 32 + fr, fq * 8);
#define PG8_SA(b, h) (((b) * 2 + (h)) * HTB)
#define PG8_SB(b, h) ((4 + (b) * 2 + (h)) * HTB)
#define PG8_STAGE(bufoff, gbase, voff) do { _Pragma("unroll") for (int _i = 0; _i < 2; ++_i) \
        __builtin_amdgcn_global_load_lds((const unsigned*)((const char*)(gbase) + (voff)[_i]), (PG8_LAS unsigned*)(lds + (bufoff) + ldsw + _i * 8192), 16, 0, 0); } while (0)
#define PG8_STAGEA(bufoff, gbase, voff) do { __builtin_amdgcn_global_load_lds((const unsigned*)((const char*)(gbase) + (voff)[0]), (PG8_LAS unsigned*)(lds + (bufoff) + ldsw), 16, 0, 0); \
        if (MT == 4 || wr == 0) __builtin_amdgcn_global_load_lds((const unsigned*)((const char*)(gbase) + (voff)[1]), (PG8_LAS unsigned*)(lds + (bufoff) + ldsw + 8192), 16, 0, 0); } while (0)
#define PG8_WAIT_VA(nfull, nred) do { if (MT == 4 || wr == 0) asm volatile("s_waitcnt vmcnt(" #nfull ")" ::: "memory"); else asm volatile("s_waitcnt vmcnt(" #nred ")" ::: "memory"); } while (0)
#define PG8_LDA(dst, b, h) do { _Pragma("unroll") for (int m = 0; m < MT; ++m) _Pragma("unroll") for (int k = 0; k < 2; ++k) dst[m][k] = *(const PG8_LAS bf16x8*)(lds + PG8_SA(b, h) + aoff + m * 2048 + k * 1024); } while (0)
#define PG8_LDB(dst, b, h) do { _Pragma("unroll") for (int n = 0; n < 2; ++n) _Pragma("unroll") for (int k = 0; k < 2; ++k) dst[n][k] = *(const PG8_LAS bf16x8*)(lds + PG8_SB(b, h) + boff + n * 2048 + k * 1024); } while (0)
#define PG8_MMA(ai, bj, At, Bt) do { __builtin_amdgcn_s_setprio(1); _Pragma("unroll") for (int m = 0; m < MT; ++m) _Pragma("unroll") for (int n = 0; n < 2; ++n) _Pragma("unroll") for (int k = 0; k < 2; ++k) \
        acc[ai][bj][m][n] = __builtin_amdgcn_mfma_f32_16x16x32_bf16(Bt[n][k], At[m][k], acc[ai][bj][m][n], 0, 0, 0); __builtin_amdgcn_s_setprio(0); } while (0)
#define PG8_WAIT_V(n) asm volatile("s_waitcnt vmcnt(" #n ")" ::: "memory")
#define PG8_WAIT_L(n) asm volatile("s_waitcnt lgkmcnt(" #n ")" ::: "memory")
#define PG8_BAR __builtin_amdgcn_s_barrier()
#define PG8_SCHED __builtin_amdgcn_sched_barrier(0)
    Unit cur, nxt; int ui = 0;
    if (!S.next(0, cur)) return;
    f32x4 acc[2][2][MT][2];
#pragma unroll
    for (int a = 0; a < 2; ++a)
#pragma unroll
        for (int b = 0; b < 2; ++b)
#pragma unroll
            for (int m = 0; m < MT; ++m)
#pragma unroll
                for (int n = 0; n < 2; ++n) acc[a][b][m][n] = (f32x4){0.f, 0.f, 0.f, 0.f};
    bf16x8 At[MT][2], B0[2][2], B1[2][2];
    const char* cA = (const char*)g.A + (size_t)cur.pm * tstepA; const char* cB = (const char*)g.Bt + (size_t)cur.pn * tstepB;
    S.a_ready(cur);
    if constexpr (SP2) {
        PG8_STAGE(PG8_SB(0, 0), cB, voffB); PG8_STAGE(PG8_SB(0, 1), cB + hstepB, voffB); PG8_STAGEA(PG8_SA(0, 0), cA, voffA); PG8_STAGEA(PG8_SA(0, 1), cA + hstepA, voffA);
        if (wr == 1) PG8_BAR;
        PG8_WAIT_VA(2, 1); PG8_BAR;
        PG8_STAGE(PG8_SB(1, 0), cB + kstep, voffB); PG8_STAGEA(PG8_SA(1, 0), cA + kstep, voffA); PG8_STAGE(PG8_SB(1, 1), cB + hstepB + kstep, voffB);
        PG8_WAIT_VA(6, 5); PG8_BAR;
    } else {
        PG8_STAGE(PG8_SB(0, 0), cB, voffB); PG8_STAGEA(PG8_SA(0, 0), cA, voffA); PG8_STAGE(PG8_SB(0, 1), cB + hstepB, voffB); PG8_STAGEA(PG8_SA(0, 1), cA + hstepA, voffA);
        if (wr == 1) PG8_BAR;
        PG8_WAIT_V(4); PG8_BAR;
        PG8_STAGE(PG8_SB(1, 0), cB + kstep, voffB); PG8_STAGEA(PG8_SA(1, 0), cA + kstep, voffA); PG8_STAGE(PG8_SB(1, 1), cB + hstepB + kstep, voffB);
        PG8_WAIT_V(6); PG8_BAR;
    }
    for (;;) {
        const bool has_next = S.next(ui + 1, nxt);
        const char* nA = has_next ? (const char*)g.A + (size_t)nxt.pm * tstepA : cA; const char* nB = has_next ? (const char*)g.Bt + (size_t)nxt.pn * tstepB : cB;
        for (int t = 0; t < nt; t += 2) {
            const bool last = (t == nt - 2);
            const char* a1 = cA + (size_t)(t + 1) * kstep;
            const char* a2 = last ? nA : cA + (size_t)(t + 2) * kstep; const char* b2 = last ? nB : cB + (size_t)(t + 2) * kstep;
            const char* a3 = a2 + kstep; const char* b3 = b2 + kstep;
            if (last && has_next) S.a_ready(nxt);
            if constexpr (SP2) {
            PG8_LDB(B0, 0, 0); PG8_LDB(B1, 0, 1); PG8_SCHED; PG8_LDA(At, 0, 0); PG8_STAGEA(PG8_SA(1, 1), a1 + hstepA, voffA);
            PG8_WAIT_VA(8, 6); PG8_WAIT_L(0); PG8_BAR; PG8_MMA(0, 0, At, B0); PG8_MMA(0, 1, At, B1); PG8_BAR; PG8_SCHED;
            PG8_LDA(At, 0, 1); PG8_STAGE(PG8_SB(0, 0), b2, voffB); PG8_STAGE(PG8_SB(0, 1), b2 + hstepB, voffB); PG8_STAGEA(PG8_SA(0, 0), a2, voffA);
            PG8_WAIT_VA(8, 6); PG8_WAIT_L(0); PG8_BAR; PG8_MMA(1, 0, At, B0); PG8_MMA(1, 1, At, B1); PG8_BAR; PG8_SCHED;
            PG8_LDB(B0, 1, 0); PG8_LDB(B1, 1, 1); PG8_SCHED; PG8_LDA(At, 1, 0); PG8_STAGEA(PG8_SA(0, 1), a2 + hstepA, voffA);
            PG8_WAIT_VA(8, 6); PG8_WAIT_L(0); PG8_BAR; PG8_MMA(0, 0, At, B0); PG8_MMA(0, 1, At, B1); PG8_BAR; PG8_SCHED;
            PG8_LDA(At, 1, 1); PG8_STAGE(PG8_SB(1, 0), b3, voffB); PG8_STAGE(PG8_SB(1, 1), b3 + hstepB, voffB); PG8_STAGEA(PG8_SA(1, 0), a3, voffA);
            PG8_WAIT_VA(8, 6); PG8_WAIT_L(0); PG8_BAR; PG8_MMA(1, 0, At, B0); PG8_MMA(1, 1, At, B1); PG8_BAR; PG8_SCHED;
            } else {
            PG8_LDB(B0, 0, 0); PG8_SCHED; PG8_LDA(At, 0, 0); PG8_STAGEA(PG8_SA(1, 1), a1 + hstepA, voffA);
            PG8_WAIT_L(8); PG8_BAR; PG8_WAIT_L(0); PG8_MMA(0, 0, At, B0); PG8_BAR; PG8_SCHED;
            PG8_LDB(B1, 0, 1); PG8_STAGE(PG8_SB(0, 0), b2, voffB);
            PG8_BAR; PG8_WAIT_L(0); PG8_MMA(0, 1, At, B1); PG8_BAR;
            PG8_LDA(At, 0, 1); PG8_STAGEA(PG8_SA(0, 0), a2, voffA);
            PG8_BAR; PG8_WAIT_L(0); PG8_MMA(1, 0, At, B0); PG8_BAR; PG8_SCHED;
            PG8_STAGE(PG8_SB(0, 1), b2 + hstepB, voffB);
            PG8_WAIT_V(6); PG8_BAR; PG8_MMA(1, 1, At, B1); PG8_BAR;
            PG8_LDB(B0, 1, 0); PG8_SCHED; PG8_LDA(At, 1, 0); PG8_STAGEA(PG8_SA(0, 1), a2 + hstepA, voffA);
            PG8_WAIT_L(8); PG8_BAR; PG8_WAIT_L(0); PG8_MMA(0, 0, At, B0); PG8_BAR; PG8_SCHED;
            PG8_LDB(B1, 1, 1); PG8_STAGE(PG8_SB(1, 0), b3, voffB);
            PG8_BAR; PG8_WAIT_L(0); PG8_MMA(0, 1, At, B1); PG8_BAR;
            PG8_LDA(At, 1, 1); PG8_STAGEA(PG8_SA(1, 0), a3, voffA);
            PG8_BAR; PG8_WAIT_L(0); PG8_MMA(1, 0, At, B0); PG8_BAR; PG8_SCHED;
            PG8_STAGE(PG8_SB(1, 1), b3 + hstepB, voffB);
            PG8_WAIT_V(6); PG8_BAR; PG8_MMA(1, 1, At, B1); PG8_BAR;
            }
        }
        if constexpr (ALIGN_EPI) { if (wr == 0) PG8_BAR; }
        if constexpr (!Epi::AFTER_DRAIN) { E(acc, cur, wr, wc, fr, fq); S.done(cur); }
        if (!has_next) break;
#pragma unroll
        for (int a = 0; a < 2; ++a)
#pragma unroll
            for (int b = 0; b < 2; ++b)
#pragma unroll
                for (int m = 0; m < MT; ++m)
#pragma unroll
                    for (int n = 0; n < 2; ++n) acc[a][b][m][n] = (f32x4){0.f, 0.f, 0.f, 0.f};
        cur = nxt; cA = nA; cB = nB; ++ui;
        if constexpr (ALIGN_EPI) { if (wr == 1) PG8_BAR; }
    }
    PG8_WAIT_V(0);
    if constexpr (!ALIGN_EPI) { if (wr == 0) PG8_BAR; }
    PG8_BAR;
    if constexpr (Epi::AFTER_DRAIN) { E.fused(acc, cur, wr, wc, fr, fq, lds, wid, lane); S.done(cur); }
#undef PG8_SA
#undef PG8_SB
#undef PG8_STAGE
#undef PG8_LDA
#undef PG8_LDB
#undef PG8_MMA
#undef PG8_WAIT_V
#undef PG8_WAIT_VA
#undef PG8_STAGEA
#undef PG8_WAIT_L
#undef PG8_BAR
#undef PG8_SCHED
}
}
#define GAS __attribute__((address_space(1)))
#define LAS __attribute__((address_space(3)))
typedef unsigned short bf16;
typedef unsigned v4u __attribute__((ext_vector_type(4)));
typedef float f32x4 __attribute__((ext_vector_type(4)));
typedef short bf16x8 __attribute__((ext_vector_type(8)));
typedef GAS unsigned gu32;
typedef GAS unsigned long long gu64;
#define RLX_AGENT __ATOMIC_RELAXED, __HIP_MEMORY_SCOPE_AGENT
#define LDS_WAIT() asm volatile("s_waitcnt lgkmcnt(0)" ::: "memory")
#define VM_WAIT() asm volatile("s_waitcnt vmcnt(0)" ::: "memory")
__device__ __forceinline__ unsigned long long rt() { return __builtin_amdgcn_s_memrealtime(); }
__device__ __forceinline__ unsigned f2bf(float f) { unsigned u = __builtin_bit_cast(unsigned, f); return (u + 0x7fffu + ((u >> 16) & 1u)) >> 16; }
__device__ __forceinline__ unsigned pk2(float lo, float hi) { return f2bf(lo) | (f2bf(hi) << 16); }

#define XB_TMO      128
#define XB_XCNT(j)  (256  + 64 * (j))
#define XB_XSUB(j)  (1280 + 64 * (j))
#define XB_XGEN(j)  (2304 + 64 * (j))
#define XB_TOP      3328
#define XB_TOPGEN   3392
#define XCD_BAR_WORDS 3456
#define XB_SPIN_CAP (1u << 18)

__device__ __forceinline__ unsigned xb_ld(unsigned* p)              { return __hip_atomic_load(p, __ATOMIC_RELAXED, __HIP_MEMORY_SCOPE_AGENT); }
__device__ __forceinline__ unsigned xb_add(unsigned* p, unsigned v) { return __hip_atomic_fetch_add(p, v, __ATOMIC_RELAXED, __HIP_MEMORY_SCOPE_AGENT); }
__device__ __forceinline__ unsigned xb_xcc_id() { return (unsigned)__builtin_amdgcn_s_getreg((3 << 11) | 20) & 0xFu; }
#define XB_SPIN(cond, bar) do { unsigned _sp = 0; while (cond) { __builtin_amdgcn_s_sleep(1); \
    if ((++_sp & 255u) == 0u) { if (xb_ld(&(bar)[XB_TMO])) break; if (_sp > XB_SPIN_CAP) { atomicAdd(&(bar)[XB_TMO], 1u); break; } } } } while (0)

struct XcdBarrier {
    unsigned* bar; unsigned x;
    volatile LAS unsigned* st;
};

__device__ __forceinline__ XcdBarrier xcd_barrier_post(unsigned* bar, volatile LAS unsigned* st) {
    XcdBarrier b; b.bar = bar; b.x = xb_xcc_id(); b.st = st;
    if (threadIdx.x == 0) (void)xb_add(&bar[XB_XCNT(b.x)], 1u);
    return b;
}
__device__ __forceinline__ void xcd_barrier_complete(unsigned* bar, unsigned x, unsigned& nloc, unsigned& nx) {
    const unsigned G = gridDim.x * gridDim.y * gridDim.z;
    unsigned sum, cnt, mine, sp = 0u;
    for (;;) {
        sum = 0u; cnt = 0u; mine = 0u;
#pragma unroll
        for (unsigned j = 0; j < 16; ++j) { const unsigned c = xb_ld(&bar[XB_XCNT(j)]); sum += c; cnt += (c > 0u) ? 1u : 0u; mine = (j == x) ? c : mine; }
        if (sum == G) break;
        __builtin_amdgcn_s_sleep(1);
        if ((++sp & 255u) == 0u) { if (xb_ld(&bar[XB_TMO])) break; if (sp > XB_SPIN_CAP) { atomicAdd(&bar[XB_TMO], 1u); break; } }
    }
    nloc = mine > 0u ? mine : 1u; nx = cnt > 0u ? cnt : 1u;
}

__device__ __forceinline__ void xcd_barrier(const XcdBarrier& b) {
    asm volatile("s_waitcnt vmcnt(0)" ::: "memory");
    __syncthreads();
    if (threadIdx.x == 0) {
        unsigned* bar = b.bar;
        __builtin_amdgcn_s_waitcnt(0);
        unsigned nloc = b.st[0], nx = b.st[1];
        if (nloc == 0u) { xcd_barrier_complete(bar, b.x, nloc, nx); b.st[0] = nloc; b.st[1] = nx; }
        const unsigned old = xb_add(&bar[XB_XSUB(b.x)], 1u);
        const unsigned gen = old / nloc;
        if (old + 1u == (gen + 1u) * nloc) {
            __builtin_amdgcn_fence(__ATOMIC_RELEASE, "agent");
            asm volatile("s_waitcnt vmcnt(0)" ::: "memory");
            const unsigned og = xb_add(&bar[XB_TOP], 1u);
            const unsigned tg = og / nx;
            if (og + 1u == (tg + 1u) * nx) xb_add(&bar[XB_TOPGEN], 1u);
            else XB_SPIN(xb_ld(&bar[XB_TOPGEN]) == tg, bar);
            __builtin_amdgcn_fence(__ATOMIC_ACQUIRE, "agent");
            xb_add(&bar[XB_XGEN(b.x)], 1u);
            asm volatile("s_waitcnt vmcnt(0)" ::: "memory");
        } else {
            XB_SPIN(xb_ld(&bar[XB_XGEN(b.x)]) == gen, bar);
            __builtin_amdgcn_fence(__ATOMIC_ACQUIRE, "agent");
            asm volatile("s_waitcnt vmcnt(0)" ::: "memory");
        }
    }
    __syncthreads();
}
namespace mk {
typedef float f32x16 __attribute__((ext_vector_type(16)));
typedef float f32x2_t __attribute__((ext_vector_type(2)));
typedef __bf16 bf16x2_t __attribute__((ext_vector_type(2)));

constexpr int DM = 1024, M_CTX = 4096, MT = 12288, NL = 4, NPROJP = 2048, DFF = 4096, NGT = 384, GT_LAT0 = 128;
constexpr float EPS = 1e-6f, LOG2E = 1.4426950408889634f, NEGBIG = -1e30f;
constexpr int C_NAQ = 0, C_NAK = 256, C_NAV = 512, C_POOL = 768, C_CQ = 1024, C_CKV = 1280, C_KPE = 1408, C_SQ = 1440, C_SK = 1696, C_SV = 1824;

constexpr size_t MiB = 1u << 20;
constexpr size_t WS_CTL = 0, CTL_ZERO_BYTES = 64 * 1024;
constexpr size_t WS_TAB = 1 * MiB;
constexpr size_t WS_MOD = 2 * MiB;
constexpr size_t WS_BA = 3 * MiB;
constexpr size_t WS_BD = 4 * MiB;
constexpr size_t WS_PARTA = 5 * MiB;
constexpr size_t WS_PARTD = 6 * MiB;
constexpr size_t WS_WUQ = 7 * MiB;
constexpr size_t WS_WUKV = 8 * MiB;
constexpr size_t WS_WPOOL = 9 * MiB;
constexpr size_t WS_WIN = 10 * MiB;
constexpr size_t WS_WOUT = 26 * MiB;
constexpr size_t WS_W1 = 34 * MiB;
constexpr size_t WS_W2 = 66 * MiB;
constexpr size_t WS_CKNA = 98 * MiB;
constexpr size_t WS_CVNA = 102 * MiB;
constexpr size_t WS_CKS = 106 * MiB;
constexpr size_t WS_CVS = 108 * MiB;
constexpr size_t WS_CKM = 110 * MiB;
constexpr size_t WS_CVM = 116 * MiB;
constexpr size_t WS_X = 120 * MiB;
constexpr size_t WS_XS = 168 * MiB;
constexpr size_t WS_MIX = 192 * MiB;
constexpr size_t WS_P = 216 * MiB;
constexpr size_t WS_QNA = 264 * MiB;
constexpr size_t WS_KNA = 270 * MiB;
constexpr size_t WS_VNA = 276 * MiB;
constexpr size_t WS_QM = 282 * MiB;
constexpr size_t WS_KM = 291 * MiB;
constexpr size_t WS_VM = 300 * MiB;
constexpr size_t WS_QS = 306 * MiB;
constexpr size_t WS_KS = 312 * MiB;
constexpr size_t WS_VS = 315 * MiB;
constexpr size_t WS_Z = 216 * MiB;
constexpr size_t WS_END = 318 * MiB;

constexpr size_t O_Y = 0, O_NAK = 12582912, O_NAV = 16777216, O_CKV = 20971520, O_KPE = 23068672, O_SK = 23592960, O_SV = 25690112;

struct Args { const float* in[32]; float* out; unsigned char* ws; };

__device__ __forceinline__ unsigned cvtpk(float lo, float hi) { f32x2_t v = {lo, hi}; bf16x2_t b = __builtin_convertvector(v, bf16x2_t); return __builtin_bit_cast(unsigned, b); }
__device__ __forceinline__ float bflo(unsigned w) { return __uint_as_float(w << 16); }
__device__ __forceinline__ float bfhi(unsigned w) { return __uint_as_float(w & 0xffff0000u); }
__device__ __forceinline__ int swz(int x) { return (x & ~12) | ((x & 4) << 1) | ((x & 8) >> 1); }
__device__ __forceinline__ f32x16 mfma32(bf16x8 a, bf16x8 b, f32x16 c) { return __builtin_amdgcn_mfma_f32_32x32x16_bf16(a, b, c, 0, 0, 0); }
__device__ __forceinline__ bf16x8 pack8(float a0, float a1, float a2, float a3, float a4, float a5, float a6, float a7) {
    v4u w; w.x = cvtpk(a0, a1); w.y = cvtpk(a2, a3); w.z = cvtpk(a4, a5); w.w = cvtpk(a6, a7); return __builtin_bit_cast(bf16x8, w); }
#define PACK8ARR(a, o) pack8((a)[(o)], (a)[(o) + 1], (a)[(o) + 2], (a)[(o) + 3], (a)[(o) + 4], (a)[(o) + 5], (a)[(o) + 6], (a)[(o) + 7])
__device__ __forceinline__ size_t pblk(int row, int col) { return ((size_t)((row >> 5) * 256 + (col >> 3)) << 8) + (size_t)(((row & 31) << 3) + (col & 7)); }
template <bool F32> __device__ __forceinline__ size_t sidx(int row, size_t pitch, int col) { return F32 ? (size_t)row * pitch + (size_t)col : pblk(row, col); }
template <bool F32> __device__ __forceinline__ void load8(const void* base, size_t elem, float (&f)[8]) {
    if (F32) { const f32x4* p = (const f32x4*)((const float*)base + elem); const f32x4 a = p[0], b = p[1];
        f[0] = a[0]; f[1] = a[1]; f[2] = a[2]; f[3] = a[3]; f[4] = b[0]; f[5] = b[1]; f[6] = b[2]; f[7] = b[3]; }
    else { const v4u w = *(const v4u*)((const bf16*)base + elem);
        f[0] = bflo(w.x); f[1] = bfhi(w.x); f[2] = bflo(w.y); f[3] = bfhi(w.y); f[4] = bflo(w.z); f[5] = bfhi(w.z); f[6] = bflo(w.w); f[7] = bfhi(w.w); }
}
__device__ __forceinline__ void store8f(float* p, const float (&f)[8]) { ((f32x4*)p)[0] = (f32x4){f[0], f[1], f[2], f[3]}; ((f32x4*)p)[1] = (f32x4){f[4], f[5], f[6], f[7]}; }

struct TokInfo { int lat; int b; int t; };
__device__ __forceinline__ TokInfo tok_info(int row) { TokInfo r; if (row < M_CTX) { r.lat = 0; r.b = row >> 8; r.t = row & 255; } else { r.lat = 1; r.b = (row - M_CTX) >> 11; r.t = (row - M_CTX) & 2047; } return r; }


template <bool F32, bool NORM>
__device__ __forceinline__ void head_norm_task(const void* src, size_t pitch, int row0, int col, const float* gain, bool isK, float oscale,
                                               const float* ropeS, int prow, int pcol, bf16* dst  , int tile, float* fout  , int lane) {
    const int tok = lane & 31;
    float v[64];
#pragma unroll
    for (int c = 0; c < 8; ++c) { float f[8]; load8<F32>(src, sidx<F32>(row0 + tok, pitch, col + 8 * c), f);
#pragma unroll
        for (int e = 0; e < 8; ++e) v[8 * c + e] = f[e]; }
    if (NORM) {
        float ss = 0.f;
#pragma unroll
        for (int d = 0; d < 64; ++d) ss += v[d] * v[d];
        const float rs = 1.0f / sqrtf(ss * (1.0f / 64.0f) + EPS);
#pragma unroll
        for (int d = 0; d < 64; ++d) v[d] = v[d] * rs * gain[d];
    }
    if (fout) {
#pragma unroll
        for (int c = 0; c < 16; ++c) ((f32x4*)fout)[c] = (f32x4){v[4 * c], v[4 * c + 1], v[4 * c + 2], v[4 * c + 3]};
    }
    if (ropeS) {
#pragma unroll
        for (int i = 0; i < 16; ++i) {
            const float cr = ropeS[prow * 16 + i], sr = ropeS[1024 + prow * 16 + i], cc = ropeS[pcol * 16 + i], sc = ropeS[1024 + pcol * 16 + i];
            const float a1 = v[i], a2 = v[16 + i], b1 = v[32 + i], b2 = v[48 + i];
            v[i] = a1 * cr - a2 * sr; v[16 + i] = a1 * sr + a2 * cr; v[32 + i] = b1 * cc - b2 * sc; v[48 + i] = b1 * sc + b2 * cc;
        }
    }
    if (oscale != 1.0f) {
#pragma unroll
        for (int d = 0; d < 64; ++d) v[d] *= oscale;
    }
    const int slot = isK ? swz(tok) : tok;
    bf16* d0 = dst + (size_t)tile * 2048;
#pragma unroll
    for (int c = 0; c < 4; ++c)
#pragma unroll
        for (int hf = 0; hf < 2; ++hf) *(bf16x8*)(d0 + c * 512 + (hf * 32 + slot) * 8) = PACK8ARR(v, 16 * c + 8 * hf);
}

template <bool F32>
__device__ __forceinline__ void vtrans_task(const void* src, size_t pitch, int row0, int col, bf16* dst  , int tile, float* fout, int fpitch, int lane) {
    const int i = lane & 31, kh = lane >> 5; const int tokp = swz(i);
    bf16x8 af[4];
#pragma unroll
    for (int kc = 0; kc < 4; ++kc) { float f[8]; load8<F32>(src, sidx<F32>(row0 + tokp, pitch, col + 16 * kc + 8 * kh), f);
        if (fout) store8f(fout + (size_t)tokp * fpitch + 16 * kc + 8 * kh, f);
        af[kc] = PACK8ARR(f, 0); }
    v4u i0 = {0u, 0u, 0u, 0u}, i1 = {0u, 0u, 0u, 0u};
    { const int j0 = i - 8 * kh; const int j1 = i - 16 - 8 * kh;
      unsigned w0[4] = {0u, 0u, 0u, 0u}, w1[4] = {0u, 0u, 0u, 0u};
#pragma unroll
      for (int j = 0; j < 8; ++j) { const unsigned one = 0x3F80u << (16 * (j & 1)); if (j0 == j) w0[j >> 1] |= one; if (j1 == j) w1[j >> 1] |= one; }
      i0 = (v4u){w0[0], w0[1], w0[2], w0[3]}; i1 = (v4u){w1[0], w1[1], w1[2], w1[3]}; }
    const bf16x8 I0 = __builtin_bit_cast(bf16x8, i0), I1 = __builtin_bit_cast(bf16x8, i1);
    bf16* d0 = dst + (size_t)tile * 2048;
#pragma unroll
    for (int ft = 0; ft < 2; ++ft) {
        f32x16 acc = {0.f, 0.f, 0.f, 0.f, 0.f, 0.f, 0.f, 0.f, 0.f, 0.f, 0.f, 0.f, 0.f, 0.f, 0.f, 0.f};
        acc = mfma32(af[2 * ft], I0, acc); acc = mfma32(af[2 * ft + 1], I1, acc);
#pragma unroll
        for (int s = 0; s < 2; ++s) *(bf16x8*)(d0 + ((ft * 2 + s) * 64 + lane) * 8) = PACK8ARR(acc, 8 * s);
    }
}

__device__ __forceinline__ void rope_tail32(float (&t0)[8], float (&t1)[8], const float* ropeM, int prow, int pcol, int h2) {
#pragma unroll
    for (int e = 0; e < 8; ++e) {
        const float p0 = __shfl_xor(t0[e], 32), p1 = __shfl_xor(t1[e], 32);
        const float cr = ropeM[prow * 8 + e], sr = ropeM[512 + prow * 8 + e], cc = ropeM[pcol * 8 + e], sc = ropeM[512 + pcol * 8 + e];
        t0[e] = t0[e] * cr + (h2 ? p0 : -p0) * sr;
        t1[e] = t1[e] * cc + (h2 ? p1 : -p1) * sc;
    }
}

__device__ __forceinline__ void mla_q_task(const bf16* P, int row0, const float* ga  , const bf16* wuqT  , const LAS bf16x8* wl  , int head, const float* gq  ,
                                           const float* ropeM, bf16* dst  , int tile, int lane) {
    const int tok = lane & 31, kh = lane >> 5; const int row = row0 + tok;
    bf16x8 bfr[16]; float ss = 0.f;
    {
        v4u raw[16];
#pragma unroll
        for (int kc = 0; kc < 16; ++kc) raw[kc] = *(const v4u*)(P + pblk(row, C_CQ + 16 * kc + 8 * kh));
#pragma unroll
        for (int kc = 0; kc < 16; ++kc) { const v4u w = raw[kc];
            ss += (bflo(w.x) * bflo(w.x) + bfhi(w.x) * bfhi(w.x)) + (bflo(w.y) * bflo(w.y) + bfhi(w.y) * bfhi(w.y)) + (bflo(w.z) * bflo(w.z) + bfhi(w.z) * bfhi(w.z)) + (bflo(w.w) * bflo(w.w) + bfhi(w.w) * bfhi(w.w)); }
        ss += __shfl_xor(ss, 32);
        const float rs = 1.0f / sqrtf(ss * (1.0f / 256.0f) + EPS);
#pragma unroll
        for (int kc = 0; kc < 16; ++kc) { const v4u w = raw[kc];
            if (wl) bfr[kc] = pack8(bflo(w.x) * rs, bfhi(w.x) * rs, bflo(w.y) * rs, bfhi(w.y) * rs, bflo(w.z) * rs, bfhi(w.z) * rs, bflo(w.w) * rs, bfhi(w.w) * rs);
            else { const f32x4 g0 = *(const f32x4*)(ga + 16 * kc + 8 * kh), g1 = *(const f32x4*)(ga + 16 * kc + 8 * kh + 4);
                bfr[kc] = pack8(bflo(w.x) * rs * g0[0], bfhi(w.x) * rs * g0[1], bflo(w.y) * rs * g0[2], bfhi(w.y) * rs * g0[3], bflo(w.z) * rs * g1[0], bfhi(w.z) * rs * g1[1], bflo(w.w) * rs * g1[2], bfhi(w.w) * rs * g1[3]); } }
        __builtin_amdgcn_sched_barrier(0);
    }
    f32x16 acc[3];
#pragma unroll
    for (int ft = 0; ft < 3; ++ft) {
        acc[ft] = (f32x16){0.f, 0.f, 0.f, 0.f, 0.f, 0.f, 0.f, 0.f, 0.f, 0.f, 0.f, 0.f, 0.f, 0.f, 0.f, 0.f};
        const bf16* wr = wuqT + (size_t)(head * 96 + 32 * ft + swz(tok)) * 256 + 8 * kh;
#pragma unroll
        for (int k8 = 0; k8 < 16; k8 += 8) { bf16x8 wv[8];
#pragma unroll
            for (int kc = 0; kc < 8; ++kc) wv[kc] = wl ? wl[(ft * 16 + k8 + kc) * 64 + lane] : *(const bf16x8*)(wr + 16 * (k8 + kc));
#pragma unroll
            for (int kc = 0; kc < 8; ++kc) acc[ft] = mfma32(wv[kc], bfr[k8 + kc], acc[ft]); }
    }
    float s2 = 0.f;
#pragma unroll
    for (int ft = 0; ft < 3; ++ft)
#pragma unroll
        for (int r = 0; r < 16; ++r) s2 += acc[ft][r] * acc[ft][r];
    s2 += __shfl_xor(s2, 32);
    const float rq = (0.10206207261596577f * LOG2E) / sqrtf(s2 * (1.0f / 96.0f) + EPS);
    const TokInfo ti = tok_info(row);
    bf16* d0 = dst + (size_t)tile * 3072;
#pragma unroll
    for (int ft = 0; ft < 3; ++ft) {
        float o0[8], o1[8];
        const f32x4 ga0 = *(const f32x4*)(gq + 32 * ft + 8 * kh), ga1 = *(const f32x4*)(gq + 32 * ft + 8 * kh + 4), gb0 = *(const f32x4*)(gq + 32 * ft + 16 + 8 * kh), gb1 = *(const f32x4*)(gq + 32 * ft + 16 + 8 * kh + 4);
#pragma unroll
        for (int e = 0; e < 4; ++e) { o0[e] = acc[ft][e] * rq * ga0[e]; o0[4 + e] = acc[ft][4 + e] * rq * ga1[e]; o1[e] = acc[ft][8 + e] * rq * gb0[e]; o1[4 + e] = acc[ft][12 + e] * rq * gb1[e]; }
        if (ft == 2 && ti.lat) rope_tail32(o0, o1, ropeM, ti.t >> 6, ti.t & 63, kh);
        *(bf16x8*)(d0 + (2 * ft) * 512 + (kh * 32 + tok) * 8) = PACK8ARR(o0, 0);
        *(bf16x8*)(d0 + (2 * ft + 1) * 512 + (kh * 32 + tok) * 8) = PACK8ARR(o1, 0);
    }
}

template <bool F32, bool NORM>
__device__ __forceinline__ void mla_kv_task(const void* ckv_src, size_t ckv_pitch, size_t ckv_col, const void* kpe_src, size_t kpe_pitch, size_t kpe_col, int row0,
                                            const float* gkv  , const bf16* wukvT  , const LAS bf16x8* wl  , int head, const float* gk  , const float* ropeM, int seq_t0  ,
                                            bf16* kdst  , bf16* vdst  , int tile, float* ckv_out, float* kpe_out, int lane) {
    const int tok = lane & 31, kh = lane >> 5; const int row = row0 + tok;
    bf16x8 bfr[8];
    {
        float cv[8][8]; float ss = 0.f;
#pragma unroll
        for (int kc = 0; kc < 8; ++kc) { load8<F32>(ckv_src, sidx<F32>(row, ckv_pitch, (int)ckv_col + 16 * kc + 8 * kh), cv[kc]);
#pragma unroll
            for (int e = 0; e < 8; ++e) ss += cv[kc][e] * cv[kc][e]; }
        if (NORM) {
            ss += __shfl_xor(ss, 32);
            const float rs = 1.0f / sqrtf(ss * (1.0f / 128.0f) + EPS);
#pragma unroll
            for (int kc = 0; kc < 8; ++kc) { const f32x4 g0 = *(const f32x4*)(gkv + 16 * kc + 8 * kh), g1 = *(const f32x4*)(gkv + 16 * kc + 8 * kh + 4);
#pragma unroll
                for (int e = 0; e < 4; ++e) { cv[kc][e] = cv[kc][e] * rs * g0[e]; cv[kc][4 + e] = cv[kc][4 + e] * rs * g1[e]; } }
        }
#pragma unroll
        for (int kc = 0; kc < 8; ++kc) { if (ckv_out) store8f(ckv_out + (size_t)tok * 128 + 16 * kc + 8 * kh, cv[kc]); bfr[kc] = PACK8ARR(cv[kc], 0); }
    }
    __builtin_amdgcn_sched_barrier(0);
    f32x16 an[2];
#pragma unroll
    for (int ft = 0; ft < 2; ++ft) {
        an[ft] = (f32x16){0.f, 0.f, 0.f, 0.f, 0.f, 0.f, 0.f, 0.f, 0.f, 0.f, 0.f, 0.f, 0.f, 0.f, 0.f, 0.f};
        const bf16* wr = wukvT + (size_t)(head * 128 + 32 * ft + swz(tok)) * 128 + 8 * kh;
        { bf16x8 wv[8];
#pragma unroll
          for (int kc = 0; kc < 8; ++kc) wv[kc] = wl ? wl[(ft * 8 + kc) * 64 + lane] : *(const bf16x8*)(wr + 16 * kc);
#pragma unroll
          for (int kc = 0; kc < 8; ++kc) an[ft] = mfma32(wv[kc], bfr[kc], an[ft]); }
    }
    __builtin_amdgcn_sched_barrier(0);
    float t0[8], t1[8];
    load8<F32>(kpe_src, sidx<F32>(row, kpe_pitch, (int)kpe_col + 8 * kh), t0);
    load8<F32>(kpe_src, sidx<F32>(row, kpe_pitch, (int)kpe_col + 16 + 8 * kh), t1);
    if (kpe_out) { store8f(kpe_out + (size_t)tok * 32 + 8 * kh, t0); store8f(kpe_out + (size_t)tok * 32 + 16 + 8 * kh, t1); }
    float s2 = 0.f;
#pragma unroll
    for (int ft = 0; ft < 2; ++ft)
#pragma unroll
        for (int r = 0; r < 16; ++r) s2 += an[ft][r] * an[ft][r];
#pragma unroll
    for (int e = 0; e < 8; ++e) s2 += t0[e] * t0[e] + t1[e] * t1[e];
    s2 += __shfl_xor(s2, 32);
    const float rk = 1.0f / sqrtf(s2 * (1.0f / 96.0f) + EPS);
    const int slot = kh * 32 + swz(tok);
    bf16* kd = kdst + (size_t)tile * 3072;
#pragma unroll
    for (int ft = 0; ft < 2; ++ft) {
        float o0[8], o1[8];
        const f32x4 ga0 = *(const f32x4*)(gk + 32 * ft + 8 * kh), ga1 = *(const f32x4*)(gk + 32 * ft + 8 * kh + 4), gb0 = *(const f32x4*)(gk + 32 * ft + 16 + 8 * kh), gb1 = *(const f32x4*)(gk + 32 * ft + 16 + 8 * kh + 4);
#pragma unroll
        for (int e = 0; e < 4; ++e) { o0[e] = an[ft][e] * rk * ga0[e]; o0[4 + e] = an[ft][4 + e] * rk * ga1[e]; o1[e] = an[ft][8 + e] * rk * gb0[e]; o1[4 + e] = an[ft][12 + e] * rk * gb1[e]; }
        *(bf16x8*)(kd + (2 * ft) * 512 + slot * 8) = PACK8ARR(o0, 0);
        *(bf16x8*)(kd + (2 * ft + 1) * 512 + slot * 8) = PACK8ARR(o1, 0);
    }
    {
        const f32x4 ga0 = *(const f32x4*)(gk + 64 + 8 * kh), ga1 = *(const f32x4*)(gk + 64 + 8 * kh + 4), gb0 = *(const f32x4*)(gk + 80 + 8 * kh), gb1 = *(const f32x4*)(gk + 80 + 8 * kh + 4);
#pragma unroll
        for (int e = 0; e < 4; ++e) { t0[e] = t0[e] * rk * ga0[e]; t0[4 + e] = t0[4 + e] * rk * ga1[e]; t1[e] = t1[e] * rk * gb0[e]; t1[4 + e] = t1[4 + e] * rk * gb1[e]; }
        if (ropeM) { const int t = seq_t0 + tok; rope_tail32(t0, t1, ropeM, t >> 6, t & 63, kh); }
        *(bf16x8*)(kd + 4 * 512 + slot * 8) = PACK8ARR(t0, 0);
        *(bf16x8*)(kd + 5 * 512 + slot * 8) = PACK8ARR(t1, 0);
    }
    __builtin_amdgcn_sched_barrier(0);
    bf16x8 afr[8];
    { const int srcl = kh * 32 + swz(tok);
#pragma unroll
      for (int kc = 0; kc < 8; ++kc) { const v4u w = __builtin_bit_cast(v4u, bfr[kc]); v4u o;
          o.x = (unsigned)__shfl((int)w.x, srcl); o.y = (unsigned)__shfl((int)w.y, srcl); o.z = (unsigned)__shfl((int)w.z, srcl); o.w = (unsigned)__shfl((int)w.w, srcl);
          afr[kc] = __builtin_bit_cast(bf16x8, o); } }
    bf16* vd = vdst + (size_t)tile * 2048;
#pragma unroll
    for (int dvt = 0; dvt < 2; ++dvt) {
        f32x16 av = {0.f, 0.f, 0.f, 0.f, 0.f, 0.f, 0.f, 0.f, 0.f, 0.f, 0.f, 0.f, 0.f, 0.f, 0.f, 0.f};
        const bf16* wr = wukvT + (size_t)(head * 128 + 64 + 32 * dvt + tok) * 128 + 8 * kh;
        { bf16x8 wv[8];
#pragma unroll
          for (int kc = 0; kc < 8; ++kc) wv[kc] = wl ? wl[(16 + dvt * 8 + kc) * 64 + lane] : *(const bf16x8*)(wr + 16 * kc);
#pragma unroll
          for (int kc = 0; kc < 8; ++kc) av = mfma32(afr[kc], wv[kc], av); }
#pragma unroll
        for (int s = 0; s < 2; ++s) *(bf16x8*)(vd + ((dvt * 2 + s) * 64 + lane) * 8) = PACK8ARR(av, 8 * s);
    }
}

template <int DKC, int MODE, int NQ>
__device__ __forceinline__ void attn_range(float (&m)[NQ], float (&l)[NQ], f32x16 (&o)[NQ][2], const bf16x8 (&qf)[NQ][DKC], const bf16* Kb, const bf16* Vb, int ta, int tb, int lane,
                                           int seqtile0, int tq0, const LAS float* rpb_h) {
    const int hh = lane >> 5;
    bf16x8 kf[DKC];
    { const bf16x8* kp = (const bf16x8*)(Kb + (size_t)ta * (DKC * 512)) + lane;
#pragma unroll
      for (int c = 0; c < DKC; ++c) kf[c] = kp[c * 64]; }
    for (int t = ta; t < tb; ++t) {
        const bf16x8* vp = (const bf16x8*)(Vb + (size_t)t * 2048) + lane;
        const bf16x8 v00 = vp[0], v01 = vp[64], v10 = vp[128], v11 = vp[192];
        f32x16 s[NQ];
#pragma unroll
        for (int j = 0; j < NQ; ++j) { s[j] = (f32x16){0.f, 0.f, 0.f, 0.f, 0.f, 0.f, 0.f, 0.f, 0.f, 0.f, 0.f, 0.f, 0.f, 0.f, 0.f, 0.f};
#pragma unroll
            for (int c = 0; c < DKC; ++c) s[j] = mfma32(kf[c], qf[j][c], s[j]); }
        { const int tn = (t + 1 < tb) ? t + 1 : t; const bf16x8* kp = (const bf16x8*)(Kb + (size_t)tn * (DKC * 512)) + lane;
#pragma unroll
          for (int c = 0; c < DKC; ++c) kf[c] = kp[c * 64]; }
#pragma unroll
        for (int j = 0; j < NQ; ++j) {
            float p[16];
#pragma unroll
            for (int r = 0; r < 16; ++r) p[r] = s[j][r];
            if (MODE == 1) {
                const int tq = tq0 + 32 * j; const int rel = t - seqtile0, kr = rel >> 1, kcb = rel & 1; const int qr = tq >> 6, qc = tq & 63;
                int cs = qc - 8; cs = cs < 0 ? 0 : (cs > 48 ? 48 : cs);
                const int kb = 32 * kcb + 8 * hh;
                const LAS float* bp = rpb_h + ((kr - qr + 7) * 31 + kb - qc + 15);
                const int vb0 = kb - cs;
#pragma unroll
                for (int r = 0; r < 16; ++r) { const int cr = 16 * (r >> 3) + (r & 7); const bool valid = (unsigned)(vb0 + cr) < 16u; p[r] = valid ? p[r] + bp[cr] : NEGBIG; }
            } else if (MODE == 2) {
                const int sb = (t - seqtile0) * 32 + 8 * hh - (tq0 + 32 * j);
#pragma unroll
                for (int r = 0; r < 16; ++r) { const int d = sb + 16 * (r >> 3) + (r & 7); p[r] = (d <= 128 && d >= -128) ? p[r] : NEGBIG; }
            }
            float mx = fmaxf(fmaxf(p[0], p[1]), p[2]);
#pragma unroll
            for (int r = 3; r < 15; r += 2) mx = fmaxf(fmaxf(mx, p[r]), p[r + 1]);
            mx = fmaxf(mx, p[15]);
            mx = fmaxf(mx, __shfl_xor(mx, 32));
            const bool need = mx > m[j] + 8.0f;
            if (__any(need)) {
                const float mn = need ? mx : m[j]; const float alpha = __builtin_amdgcn_exp2f(m[j] - mn); m[j] = mn; l[j] *= alpha;
#pragma unroll
                for (int r = 0; r < 16; ++r) { o[j][0][r] *= alpha; o[j][1][r] *= alpha; }
            }
            const float mj = m[j]; float sum = 0.f;
#pragma unroll
            for (int r = 0; r < 16; ++r) { p[r] = __builtin_amdgcn_exp2f(p[r] - mj); sum += p[r]; }
            l[j] += sum;
            const bf16x8 pf0 = PACK8ARR(p, 0), pf1 = PACK8ARR(p, 8);
            o[j][0] = mfma32(v00, pf0, o[j][0]); o[j][0] = mfma32(v01, pf1, o[j][0]);
            o[j][1] = mfma32(v10, pf0, o[j][1]); o[j][1] = mfma32(v11, pf1, o[j][1]);
        }
    }
}

__device__ __forceinline__ void attn_store(float m, float l, const f32x16& o0, const f32x16& o1, bool has_sink, float sinkv, bf16* mix_row  , int lane) {
    typedef unsigned u32x2v __attribute__((ext_vector_type(2)));
    const int hh = lane >> 5;
    float lt = l + __shfl_xor(l, 32);
    if (has_sink) lt += __builtin_amdgcn_exp2f(sinkv * LOG2E - m);
    const float inv = 1.0f / lt;
#pragma unroll
    for (int g = 0; g < 4; ++g) {
        u32x2v w0, w1;
        w0.x = cvtpk(o0[4 * g] * inv, o0[4 * g + 1] * inv); w0.y = cvtpk(o0[4 * g + 2] * inv, o0[4 * g + 3] * inv);
        w1.x = cvtpk(o1[4 * g] * inv, o1[4 * g + 1] * inv); w1.y = cvtpk(o1[4 * g + 2] * inv, o1[4 * g + 3] * inv);
        *(u32x2v*)(mix_row + 8 * g + 4 * hh) = w0;
        *(u32x2v*)(mix_row + 32 + 8 * g + 4 * hh) = w1;
    }
}

template <int DKC, int NQ> __device__ __forceinline__ void load_q(bf16x8 (&qf)[NQ][DKC], const bf16* Qb  , int tile, int lane) {
#pragma unroll
    for (int j = 0; j < NQ; ++j) { const bf16x8* qp = (const bf16x8*)(Qb + (size_t)(tile + j) * (DKC * 512)) + lane;
#pragma unroll
        for (int c = 0; c < DKC; ++c) qf[j][c] = qp[c * 64]; }
}
#define ATTN_INIT(NQ_) float m[NQ_], lsum[NQ_]; f32x16 o[NQ_][2]; _Pragma("unroll") for (int j_ = 0; j_ < NQ_; ++j_) { m[j_] = NEGBIG; lsum[j_] = 0.f; \
    o[j_][0] = (f32x16){0.f, 0.f, 0.f, 0.f, 0.f, 0.f, 0.f, 0.f, 0.f, 0.f, 0.f, 0.f, 0.f, 0.f, 0.f, 0.f}; o[j_][1] = o[j_][0]; }


__device__ __forceinline__ void make_q64(bf16x8 (&qf)[2][4], const bf16* P, int tile, int col, const float* gain, float qscale, const float* ropeS  , int lane) {
    const int q = lane & 31, kh = lane >> 5;
    f32x4 g[4][2];
#pragma unroll
    for (int c = 0; c < 4; ++c) { g[c][0] = *(const f32x4*)(gain + 16 * c + 8 * kh); g[c][1] = *(const f32x4*)(gain + 16 * c + 8 * kh + 4); }
#pragma unroll
    for (int j = 0; j < 2; ++j) { const int row = (tile + j) * 32 + q;
        float v[4][8]; float ss = 0.f;
#pragma unroll
        for (int c = 0; c < 4; ++c) { load8<false>(P, pblk(row, col + 16 * c + 8 * kh), v[c]);
#pragma unroll
            for (int e = 0; e < 8; ++e) ss += v[c][e] * v[c][e]; }
        ss += __shfl_xor(ss, 32);
        const float rs = qscale / sqrtf(ss * (1.0f / 64.0f) + EPS);
#pragma unroll
        for (int c = 0; c < 4; ++c)
#pragma unroll
            for (int e = 0; e < 8; ++e) v[c][e] *= rs * g[c][e >> 2][e & 3];
        if (ropeS) { const TokInfo ti = tok_info(row); const int prow = ti.t >> 6, pcol = ti.t & 63;
#pragma unroll
            for (int e = 0; e < 8; ++e) { const int i = 8 * kh + e;
                const float cr = ropeS[prow * 16 + i], sr = ropeS[1024 + prow * 16 + i], cc = ropeS[pcol * 16 + i], sc = ropeS[1024 + pcol * 16 + i];
                const float a1 = v[0][e], a2 = v[1][e], b1 = v[2][e], b2 = v[3][e];
                v[0][e] = a1 * cr - a2 * sr; v[1][e] = a1 * sr + a2 * cr; v[2][e] = b1 * cc - b2 * sc; v[3][e] = b1 * sc + b2 * cc; } }
#pragma unroll
        for (int c = 0; c < 4; ++c) qf[j][c] = PACK8ARR(v[c], 0); }
}

__device__ __forceinline__ void pool_task(const bf16* P, const bf16* wp  , const float* pscale  , bf16* MIXb, int gt, int g, int lane) {
    const int tok = lane & 31, kh = lane >> 5; const int row = gt * 32 + tok; const TokInfo ti = tok_info(row);
    const int n = ti.lat ? 2048 : 256; const int w = 2 << g; const int rowbase = row - ti.t;
    const int colb = C_POOL + g * 64 + 8 * kh;
    float sum[4][8];
#pragma unroll
    for (int kc = 0; kc < 4; ++kc)
#pragma unroll
        for (int e = 0; e < 8; ++e) sum[kc][e] = 0.f;
    v4u ownr[4];
#pragma unroll
    for (int kc = 0; kc < 4; ++kc) ownr[kc] = *(const v4u*)(P + pblk(row, colb + 16 * kc));
    int cnt = 0;
    for (int j0 = 0; j0 < w; j0 += 4) {
        v4u raw[4][4]; float okf[4];
#pragma unroll
        for (int u = 0; u < 4; ++u) { const int s = ti.t - (w >> 1) + j0 + u; const bool ok = (j0 + u < w) && (s >= 0) && (s < n); okf[u] = ok ? 1.f : 0.f; cnt += ok ? 1 : 0; const int sr = ok ? s : ti.t;
#pragma unroll
            for (int kc = 0; kc < 4; ++kc) raw[u][kc] = *(const v4u*)(P + pblk(rowbase + sr, colb + 16 * kc)); }
#pragma unroll
        for (int u = 0; u < 4; ++u)
#pragma unroll
            for (int kc = 0; kc < 4; ++kc) { const v4u q = raw[u][kc]; const float k = okf[u];
                sum[kc][0] += k * bflo(q.x); sum[kc][1] += k * bfhi(q.x); sum[kc][2] += k * bflo(q.y); sum[kc][3] += k * bfhi(q.y);
                sum[kc][4] += k * bflo(q.z); sum[kc][5] += k * bfhi(q.z); sum[kc][6] += k * bflo(q.w); sum[kc][7] += k * bfhi(q.w); }
    }
    const float inv = 1.0f / (float)cnt;
    bf16x8 bfr[4];
#pragma unroll
    for (int kc = 0; kc < 4; ++kc) { const v4u q = ownr[kc];
        bfr[kc] = pack8(sum[kc][0] * inv - bflo(q.x), sum[kc][1] * inv - bfhi(q.x), sum[kc][2] * inv - bflo(q.y), sum[kc][3] * inv - bfhi(q.y),
                        sum[kc][4] * inv - bflo(q.z), sum[kc][5] * inv - bfhi(q.z), sum[kc][6] * inv - bflo(q.w), sum[kc][7] * inv - bfhi(q.w)); }
#pragma unroll
    for (int ft = 0; ft < 2; ++ft) {
        f32x16 acc = {0.f, 0.f, 0.f, 0.f, 0.f, 0.f, 0.f, 0.f, 0.f, 0.f, 0.f, 0.f, 0.f, 0.f, 0.f, 0.f};
        const bf16* wr = wp + (size_t)(32 * ft + swz(tok)) * 64 + 8 * kh;
#pragma unroll
        for (int kc = 0; kc < 4; ++kc) acc = mfma32(*(const bf16x8*)(wr + 16 * kc), bfr[kc], acc);
#pragma unroll
        for (int s = 0; s < 2; ++s) { const float* ps = pscale + 32 * ft + 16 * s + 8 * kh; const f32x4 s0 = *(const f32x4*)ps, s1 = *(const f32x4*)(ps + 4);
            *(bf16x8*)(MIXb + (size_t)row * 1024 + 256 + g * 64 + 32 * ft + 16 * s + 8 * kh) =
                pack8(acc[8 * s] * s0[0], acc[8 * s + 1] * s0[1], acc[8 * s + 2] * s0[2], acc[8 * s + 3] * s0[3], acc[8 * s + 4] * s1[0], acc[8 * s + 5] * s1[1], acc[8 * s + 6] * s1[2], acc[8 * s + 7] * s1[3]); }
    }
}
}
#ifndef REP_MLA
#define REP_MLA 1
#endif
#ifndef REP_OTH
#define REP_OTH 1
#endif
#ifndef REP_A
#define REP_A 1
#endif
#ifndef REP_A2
#define REP_A2 1
#endif
#ifndef REP_B
#define REP_B 1
#endif
#ifndef REP_D
#define REP_D 1
#endif
namespace mk {
constexpr int NWAVES = 8, NTHR = 512;
constexpr int RING_BYTES = 131072, LDSCTL_OFF = RING_BYTES, LDS_BYTES = 147456;

__device__ __forceinline__ float wave_sum(float v) {
#pragma unroll
    for (int o = 1; o < 64; o <<= 1) v += __shfl_xor(v, o);
    return v;
}

__device__ __forceinline__ void transpose_item(const float* W, int K, int N, bf16* WT, int row_off, LAS float* scr, int item, int lane) {
    const int nblk = N / 32, kb = item / nblk, nb = item % nblk, k0 = 64 * kb, n0 = 32 * nb;
    float tv[32];
#pragma unroll
    for (int i = 0; i < 32; ++i) tv[i] = __builtin_nontemporal_load(&W[(size_t)(k0 + 2 * i + (lane >> 5)) * N + n0 + (lane & 31)]);
#pragma unroll
    for (int i = 0; i < 32; ++i) scr[(2 * i + (lane >> 5)) * 33 + (lane & 31)] = tv[i];
    asm volatile("s_waitcnt lgkmcnt(0)" ::: "memory");
    const int c = lane & 7;
#pragma unroll
    for (int j = 0; j < 4; ++j) { const int n = (lane >> 3) + 8 * j; const LAS float* s = scr + (8 * c) * 33 + n;
        v4u o; o.x = cvtpk(s[0 * 33], s[1 * 33]); o.y = cvtpk(s[2 * 33], s[3 * 33]); o.z = cvtpk(s[4 * 33], s[5 * 33]); o.w = cvtpk(s[6 * 33], s[7 * 33]);
        *(v4u*)(WT + (size_t)(row_off + n0 + n) * K + k0 + 8 * c) = o; }
    asm volatile("s_waitcnt lgkmcnt(0)" ::: "memory");
}

__device__ __forceinline__ void gemv5_item(const float* W, int N, int c0, const LAS float* vec, LAS float* red, float* out, int ldo, const float* bias, int tid) {
    const int kq = tid >> 3, c4 = (tid & 7) * 4;
    const float* wp = W + (size_t)(kq * 16) * N + c0 + c4;
    f32x4 wv[16];
#pragma unroll
    for (int k = 0; k < 16; ++k) wv[k] = __builtin_nontemporal_load((const f32x4*)(wp + (size_t)k * N));
    f32x4 acc[5];
#pragma unroll
    for (int mi = 0; mi < 5; ++mi) acc[mi] = (f32x4){0.f, 0.f, 0.f, 0.f};
#pragma unroll
    for (int k = 0; k < 16; ++k) {
#pragma unroll
        for (int mi = 0; mi < 5; ++mi) acc[mi] += wv[k] * vec[mi * 1024 + kq * 16 + k]; }
#pragma unroll
    for (int mi = 0; mi < 5; ++mi) *(LAS f32x4*)(red + (kq * 5 + mi) * 32 + c4) = acc[mi];
    __syncthreads();
    if (tid < 160) { const int mi = tid >> 5, jc = tid & 31; float s = 0.f;
#pragma unroll 16
        for (int g = 0; g < 64; ++g) s += red[(g * 5 + mi) * 32 + jc];
        out[(size_t)mi * ldo + c0 + jc] = s + (bias ? bias[c0 + jc] : 0.f); }
    __syncthreads();
}

__device__ __forceinline__ int lane_id_asm() { int r; asm volatile("v_mbcnt_lo_u32_b32 %0, -1, 0\n\tv_mbcnt_hi_u32_b32 %0, -1, %0" : "=v"(r)); return r; }
typedef __attribute__((address_space(4))) const Args* ArgsP;
#define PHASE_PTRS ArgsP a = ap; asm volatile("" : "+s"(a)); unsigned char* const ws = a->ws; float* const out = a->out; (void)ws; (void)out; \
    int tid = wave_s * 64 + lane_id_asm(); asm volatile("" : "+v"(tid)); const int lane = tid & 63, wave = __builtin_amdgcn_readfirstlane(tid >> 6); const int gw = bid * NWAVES + wave, NGW = G * NWAVES; (void)lane; (void)gw; (void)NGW;
#define x_prompt (a->in[0])
#define x_sample (a->in[1])
#define cache_na_k (a->in[2])
#define cache_na_v (a->in[3])
#define cache_ckv (a->in[4])
#define cache_kpe (a->in[5])
#define cache_swa_k (a->in[6])
#define cache_swa_v (a->in[7])
#define cond_in (a->in[8])
#define c_ctx (a->in[9])
#define norm1 (a->in[10])
#define norm2 (a->in[11])
#define w_ada (a->in[12])
#define b_ada (a->in[13])
#define w_in (a->in[14])
#define w_out (a->in[15])
#define na_q_norm (a->in[16])
#define na_k_norm (a->in[17])
#define na_rpb (a->in[18])
#define pool_w (a->in[19])
#define pool_scale (a->in[20])
#define mla_q_a_norm (a->in[21])
#define mla_w_uq (a->in[22])
#define mla_kv_norm (a->in[23])
#define mla_w_ukv (a->in[24])
#define mla_q_norm (a->in[25])
#define mla_k_norm (a->in[26])
#define swa_q_norm (a->in[27])
#define swa_k_norm (a->in[28])
#define swa_sink (a->in[29])
#define mlp_w1 (a->in[30])
#define mlp_w2 (a->in[31])
#define TAB ((float*)(ws + WS_TAB))
#define MOD ((float*)(ws + WS_MOD))
#define BA ((float*)(ws + WS_BA))
#define BD ((float*)(ws + WS_BD))
#define PARTA ((float*)(ws + WS_PARTA))
#define PARTD ((float*)(ws + WS_PARTD))
#define WUQ ((bf16*)(ws + WS_WUQ))
#define WUKV ((bf16*)(ws + WS_WUKV))
#define WPOOL ((bf16*)(ws + WS_WPOOL))
#define WIN ((bf16*)(ws + WS_WIN))
#define WOUT ((bf16*)(ws + WS_WOUT))
#define W1B ((bf16*)(ws + WS_W1))
#define W2B ((bf16*)(ws + WS_W2))
#define CKNA ((bf16*)(ws + WS_CKNA))
#define CVNA ((bf16*)(ws + WS_CVNA))
#define CKS ((bf16*)(ws + WS_CKS))
#define CVS ((bf16*)(ws + WS_CVS))
#define CKM ((bf16*)(ws + WS_CKM))
#define CVM ((bf16*)(ws + WS_CVM))
#define XB ((float*)(ws + WS_X))
#define XS ((bf16*)(ws + WS_XS))
#define MIX ((bf16*)(ws + WS_MIX))
#define PB ((bf16*)(ws + WS_P))
#define ZB ((bf16*)(ws + WS_Z))
#define QNA ((bf16*)(ws + WS_QNA))
#define KNA ((bf16*)(ws + WS_KNA))
#define VNA ((bf16*)(ws + WS_VNA))
#define QM ((bf16*)(ws + WS_QM))
#define KM ((bf16*)(ws + WS_KM))
#define VM ((bf16*)(ws + WS_VM))
#define QS ((bf16*)(ws + WS_QS))
#define KS ((bf16*)(ws + WS_KS))
#define VS ((bf16*)(ws + WS_VS))
#define ROPES ((const float*)(ws + WS_TAB))
#define ROPEM ((const float*)(ws + WS_TAB) + 2048)
__global__ void __launch_bounds__(NTHR, 2) fwd_megakernel(Args args) {
    extern __shared__ __attribute__((aligned(16))) unsigned char lds_raw[];
    LAS unsigned char* lds = (LAS unsigned char*)lds_raw;
    cg::grid_group grid = cg::this_grid();
    const int wave_s = __builtin_amdgcn_readfirstlane((int)threadIdx.x >> 6);
    const int tid0 = threadIdx.x;
    const int G = gridDim.x, bid = blockIdx.x;
    ArgsP ap = (ArgsP)__builtin_amdgcn_kernarg_segment_ptr();

    for (int u = tid0; u < (LDS_BYTES - LDSCTL_OFF) / 4; u += NTHR) ((LAS unsigned*)(lds + LDSCTL_OFF))[u] = 0u;
    __syncthreads();
    { PHASE_PTRS (void)xcd_barrier_post((unsigned*)(ws + WS_CTL) + 1024, (volatile LAS unsigned*)(lds + LDSCTL_OFF + 64)); }
#define GRID_BAR() do { ArgsP a_ = ap; asm volatile("" : "+s"(a_)); XcdBarrier b_; b_.bar = (unsigned*)(a_->ws + WS_CTL) + 1024; b_.x = xb_xcc_id(); asm volatile("" : "+s"(b_.x)); \
        b_.st = (volatile LAS unsigned*)(lds + LDSCTL_OFF + 64); xcd_barrier(b_); } while (0)


    {
        PHASE_PTRS
        LAS float* vec = (LAS float*)lds; LAS float* red = (LAS float*)(lds + 20480);
        for (int i = tid; i < 5 * 1024; i += NTHR) { const int mi = i >> 10, k = i & 1023; const float c = (mi == 0) ? c_ctx[k] : cond_in[(mi - 1) * 1024 + k]; vec[i] = c / (1.0f + __expf(-c)); }
        __syncthreads();
        for (int it = bid; it < NL * 192; it += G) { const int l = it / 192, cb = it % 192;
            gemv5_item(w_ada + (size_t)l * 1024 * 6144, 6144, cb * 32, vec, red, MOD + (size_t)l * 5 * 6144, 6144, b_ada + (size_t)l * 6144, tid); }
        __syncthreads();
        if (bid == 0) {
            for (int i = tid; i < 1024; i += NTHR) { const int pos = i >> 4, f = i & 15; const float fr = exp2f(-(float)f * (1.0f / 16.0f) * 13.287712379549449f); const float a = (float)pos * fr;
                TAB[i] = cosf(a); TAB[1024 + i] = sinf(a); }
            for (int i = tid; i < 512; i += NTHR) { const int pos = i >> 3, f = i & 7; const float fr = exp2f(-(float)f * (1.0f / 8.0f) * 13.287712379549449f); const float a = (float)pos * fr;
                TAB[2048 + i] = cosf(a); TAB[2048 + 512 + i] = sinf(a); }
        }
        LAS float* scr = (LAS float*)(lds + 61440 + wave * 8704);
        constexpr int I_IN = 16 * 61, I_OUT = 16 * 32, I_1 = 16 * 128, I_2 = 64 * 32, I_UQ = 4 * 12, I_UKV = 2 * 16, I_PW = 4 * 2;
        constexpr int I_L = I_IN + I_OUT + I_1 + I_2 + I_UQ + I_UKV + I_PW;
        for (int it = gw; it < NL * I_L; it += NGW) {
            const int l = it / I_L; int r = it % I_L;
            if (r < I_IN) { transpose_item(w_in + (size_t)l * 1024 * 1952, 1024, 1952, WIN + (size_t)l * 2048 * 1024, 0, scr, r, lane); continue; } r -= I_IN;
            if (r < I_OUT) { transpose_item(w_out + (size_t)l * 1024 * 1024, 1024, 1024, WOUT + (size_t)l * 1024 * 1024, 0, scr, r, lane); continue; } r -= I_OUT;
            if (r < I_1) { transpose_item(mlp_w1 + (size_t)l * 1024 * 4096, 1024, 4096, W1B + (size_t)l * 4096 * 1024, 0, scr, r, lane); continue; } r -= I_1;
            if (r < I_2) { transpose_item(mlp_w2 + (size_t)l * 4096 * 1024, 4096, 1024, W2B + (size_t)l * 1024 * 4096, 0, scr, r, lane); continue; } r -= I_2;
            if (r < I_UQ) { transpose_item(mla_w_uq + (size_t)l * 256 * 384, 256, 384, WUQ + (size_t)l * 384 * 256, 0, scr, r, lane); continue; } r -= I_UQ;
            if (r < I_UKV) { transpose_item(mla_w_ukv + (size_t)l * 128 * 512, 128, 512, WUKV + (size_t)l * 512 * 128, 0, scr, r, lane); continue; } r -= I_UKV;
            { const int g = r >> 1; transpose_item(pool_w + (size_t)(l * 4 + g) * 4096, 64, 64, WPOOL + (size_t)(l * 4 + g) * 4096, 0, scr, r & 1, lane); }
        }
        for (int i = bid * NTHR + tid; i < NL * 96 * 128; i += G * NTHR) { const int l = i / (96 * 128), r = i % (96 * 128); *(v4u*)(WIN + (size_t)l * 2048 * 1024 + (size_t)1952 * 1024 + (size_t)r * 8) = (v4u){0u, 0u, 0u, 0u}; }
    }
    GRID_BAR();
    if (gridDim.y > 60000u) grid.sync();

    {
        PHASE_PTRS
        LAS float* vec = (LAS float*)lds; LAS float* red = (LAS float*)(lds + 20480);
        for (int it = bid; it < NL * 189; it += G) { const int l = it / 189, r = it % 189; const bool isD = r >= 61; const int cb = isD ? r - 61 : r;
            __syncthreads();
            for (int i = tid; i < 5 * 1024; i += NTHR) { const int mi = i >> 10, k = i & 1023; vec[i] = MOD[(size_t)(l * 5 + mi) * 6144 + (isD ? 3072 : 0) + k]; }
            __syncthreads();
            if (isD) gemv5_item(mlp_w1 + (size_t)l * 1024 * 4096, 4096, cb * 32, vec, red, BD + (size_t)l * 5 * 4096, 4096, nullptr, tid);
            else gemv5_item(w_in + (size_t)l * 1024 * 1952, 1952, cb * 32, vec, red, BA + (size_t)l * 5 * 2048, 2048, nullptr, tid);
        }
        for (int row = gw; row < MT; row += NGW) {
            const float* xr = (row < M_CTX) ? x_prompt + (size_t)row * 1024 : x_sample + (size_t)(row - M_CTX) * 1024; const int mi = (row < M_CTX) ? 0 : 1 + ((row - M_CTX) >> 11);
            const float* scp = MOD + (size_t)mi * 6144 + 1024; float ss = 0.f;
#pragma unroll
            for (int j = 0; j < 4; ++j) { const int c = 4 * lane + 256 * j; const f32x4 v = *(const f32x4*)(xr + c); ss += (v[0] * v[0] + v[1] * v[1]) + (v[2] * v[2] + v[3] * v[3]);
                const f32x4 g = *(const f32x4*)(norm1 + c), s = *(const f32x4*)(scp + c); const f32x4 o = v * g * (s + 1.0f);
                typedef unsigned u32x2v __attribute__((ext_vector_type(2))); u32x2v w; w.x = cvtpk(o[0], o[1]); w.y = cvtpk(o[2], o[3]); *(u32x2v*)(XS + (size_t)row * 1024 + c) = w; }
            ss = wave_sum(ss);
            if (lane < 16) PARTA[(size_t)row * 16 + lane] = (lane == 0) ? ss : 0.f;
        }
    }
    {
        PHASE_PTRS
        for (int it = gw; it < 256 * 10; it += NGW) {
            int lane = tid & 63; asm volatile("" : "+v"(lane));
            const int sub = it % 10, u = it / 10; const int l = u >> 6, b = (u >> 4) & 3, tile = u & 15;
            const size_t lb = (size_t)(l * 4 + b);
            const size_t crow0 = ((size_t)b * 4 + l) * 512;
            if (sub < 2) {
                const int h = 2 * sub + (lane >> 5);
                head_norm_task<true, false>(cache_na_k, 256, (int)crow0 + tile * 32, h * 64, nullptr, true, 1.0f, nullptr, 0, 0, CKNA + (lb * 4 + h) * 16 * 2048, tile, nullptr, lane);
            } else if (sub < 4) {
                for (int hh = 0; hh < 2; ++hh) { const int h = 2 * (sub - 2) + hh; vtrans_task<true>(cache_na_v, 256, (int)crow0 + tile * 32, h * 64, CVNA + (lb * 4 + h) * 16 * 2048, tile, nullptr, 0, lane); }
            } else if (sub == 4) {
                const int h = lane >> 5;
                head_norm_task<true, false>(cache_swa_k, 128, (int)crow0 + tile * 32, h * 64, nullptr, true, 1.0f, nullptr, 0, 0, CKS + (lb * 2 + h) * 16 * 2048, tile, nullptr, lane);
            } else if (sub == 5) {
                for (int h = 0; h < 2; ++h) vtrans_task<true>(cache_swa_v, 128, (int)crow0 + tile * 32, h * 64, CVS + (lb * 2 + h) * 16 * 2048, tile, nullptr, 0, lane);
            } else {
                const int h = sub - 6;
                mla_kv_task<true, false>(cache_ckv, 128, 0, cache_kpe, 32, 0, (int)crow0 + tile * 32, nullptr, WUKV + (size_t)l * 512 * 128, nullptr, h, mla_k_norm + l * 96, nullptr, 0,
                                         CKM + (lb * 4 + h) * 16 * 3072, CVM + (lb * 4 + h) * 16 * 2048, tile, nullptr, nullptr, lane);
            }
        }
    }
    GRID_BAR();

    int mla_seq = 0;
    for (int l = 0; l < NL; ++l) {
        for (int rep_ = 0; rep_ < REP_A; ++rep_) {
        {
            PHASE_PTRS
            pg8::Gemm g{XS, WIN + (size_t)l * 2048 * 1024, MT, NPROJP, DM}; pg8::StaticOrder S; S.init(MT, NPROJP, G, bid, 192);
            pg8::EpiScaleBias<0, true> E{PB, NPROJP, BA + (size_t)l * 5 * 2048, 2048, PARTA};
            pg8::gemm_phase<pg8::EpiScaleBias<0, true>, pg8::StaticOrder, true, true, 3>(lds, g, S, E, tid);
        }
        GRID_BAR();
        }
        for (int rep_ = 0; rep_ < REP_A2; ++rep_) {
        {
            PHASE_PTRS
            {
                const int head = bid & 3;
                const bf16* wq = WUQ + (size_t)l * 384 * 256; const bf16* wkv = WUKV + (size_t)l * 512 * 128;
                LAS bf16x8* lq = (LAS bf16x8*)lds; LAS bf16x8* lkv = (LAS bf16x8*)(lds + 49152);
                for (int p = tid; p < 48 * 64; p += NTHR) { const int f = p >> 6, ln = p & 63, ft = f >> 4, kc = f & 15;
                    const v4u w = *(const v4u*)(wq + (size_t)(head * 96 + 32 * ft + swz(ln & 31)) * 256 + 16 * kc + 8 * (ln >> 5));
                    const float* gp = mla_q_a_norm + l * 256 + 16 * kc + 8 * (ln >> 5); const f32x4 g0 = *(const f32x4*)gp, g1 = *(const f32x4*)(gp + 4);
                    lq[p] = pack8(bflo(w.x) * g0[0], bfhi(w.x) * g0[1], bflo(w.y) * g0[2], bfhi(w.y) * g0[3], bflo(w.z) * g1[0], bfhi(w.z) * g1[1], bflo(w.w) * g1[2], bfhi(w.w) * g1[3]); }
                LAS float* ltab = (LAS float*)(lds + 81920);
                for (int p = tid; p < 1344; p += NTHR) ltab[p] = (p < 96) ? mla_q_norm[l * 96 + p] : (p < 192) ? mla_k_norm[l * 96 + (p - 96)] : (p < 320) ? mla_kv_norm[l * 128 + (p - 192)] : ROPEM[p - 320];
                for (int p = tid; p < 32 * 64; p += NTHR) { const int f = p >> 6, ln = p & 63, part = f >> 4, t2 = (f >> 3) & 1, kc = f & 7; const int i5 = ln & 31;
                    const int wrow = head * 128 + (part ? 64 + 32 * t2 + i5 : 32 * t2 + swz(i5));
                    lkv[p] = *(const bf16x8*)(wkv + (size_t)wrow * 128 + 16 * kc + 8 * (ln >> 5)); }
                __syncthreads();
                if (wave < 6) {
                    for (int tg = bid >> 2; tg < 64; tg += (G >> 2)) {
                        int lane = tid & 63; asm volatile("" : "+v"(lane));
                        const int gt = tg * 6 + wave; const int row0 = gt * 32; const bool lat = gt >= GT_LAT0; const TokInfo t0i = tok_info(row0);
                        const size_t crow = ((size_t)(t0i.b * 4 + l)) * 256 + t0i.t;
                        mla_q_task(PB, row0, mla_q_a_norm + l * 256, wq, lq, head, (const float*)ltab, (const float*)(ltab + 320), QM + (size_t)head * NGT * 3072, gt, lane);
                        mla_kv_task<false, true>(PB, NPROJP, C_CKV, PB, NPROJP, C_KPE, row0, (const float*)(ltab + 192), wkv, lkv, head, (const float*)(ltab + 96), lat ? (const float*)(ltab + 320) : nullptr, t0i.t,
                                                 KM + (size_t)head * NGT * 3072, VM + (size_t)head * NGT * 2048, gt, (!lat && head == 0) ? out + O_CKV + crow * 128 : nullptr, (!lat && head == 0) ? out + O_KPE + crow * 32 : nullptr, lane);
                    }
                }
            }
            for (int it = gw; it < NGT * 6; it += NGW) {
                int lane = tid & 63; asm volatile("" : "+v"(lane));
                const int gt = it / 6, sub = it % 6; const int row0 = gt * 32; const bool lat = gt >= GT_LAT0;
                const int tok = lane & 31; const TokInfo ti = tok_info(row0 + tok);
                const TokInfo t0i = tok_info(row0);
                const size_t crow = ((size_t)(t0i.b * 4 + l)) * 256 + t0i.t;
                const int hs = lane >> 5;
                if (sub < 2) { const int h = 2 * sub + hs; head_norm_task<false, true>(PB, NPROJP, row0, C_NAK + h * 64, na_k_norm + l * 64, true, 1.0f, nullptr, 0, 0, KNA + (size_t)h * NGT * 2048, gt,
                                                                                       lat ? nullptr : out + O_NAK + (crow + tok) * 256 + h * 64, lane); }
                else if (sub == 2) { const int h = hs; head_norm_task<false, true>(PB, NPROJP, row0, C_SK + h * 64, swa_k_norm + l * 64, true, 1.0f, lat ? ROPES : nullptr, ti.t >> 6, ti.t & 63, KS + (size_t)h * NGT * 2048, gt,
                                                                                   lat ? nullptr : out + O_SK + (crow + tok) * 128 + h * 64, lane); }
                else if (sub < 5) {
                    for (int hh = 0; hh < 2; ++hh) { const int h = 2 * (sub - 3) + hh; vtrans_task<false>(PB, NPROJP, row0, C_NAV + h * 64, VNA + (size_t)h * NGT * 2048, gt, lat ? nullptr : out + O_NAV + crow * 256 + h * 64, 256, lane); }
                } else {
                    for (int h = 0; h < 2; ++h) vtrans_task<false>(PB, NPROJP, row0, C_SV + h * 64, VS + (size_t)h * NGT * 2048, gt, lat ? nullptr : out + O_SV + crow * 128 + h * 64, 128, lane);
                }
            }
        }
        GRID_BAR();
        }
        for (int rep_ = 0; rep_ < REP_B; ++rep_) {
        {
            PHASE_PTRS
            LAS float* rpb = (LAS float*)lds;
            const int vb = (G % 8 == 0) ? (bid % 8) * (G / 8) + bid / 8 : bid;
            __syncthreads();
            for (int i = tid; i < 64 + 4 * 465 + 64; i += NTHR) rpb[i] = (i >= 64 && i < 64 + 4 * 465) ? na_rpb[(size_t)l * 4 * 465 + (i - 64)] * LOG2E : 0.f;
            __syncthreads();
            if (wave < 4) {
                LAS float* xm = (LAS float*)(lds + 8192);
                LAS float* xo = (LAS float*)(lds + 16384);
                volatile LAS unsigned* cnt = (volatile LAS unsigned*)(lds + LDSCTL_OFF + 256);
                for (int rep2_ = 0; rep2_ < REP_MLA; ++rep2_)
                for (int it = vb; it < 512; it += G, ++mla_seq) {
                    const int b = it >> 7, h = (it >> 5) & 3, qb = it & 31; const int gt0 = GT_LAT0 + b * 64, gtq = gt0 + 2 * qb;
                    bf16x8 qf[2][6]; load_q<6, 2>(qf, QM + (size_t)h * NGT * 3072, gtq, lane);
                    ATTN_INIT(2)
                    const int k0 = 20 * wave, k1 = k0 + 20;
                    if (k0 < 64) attn_range<6, 0, 2>(m, lsum, o, qf, KM + (size_t)h * NGT * 3072, VM + (size_t)h * NGT * 2048, gt0 + k0, gt0 + (k1 < 64 ? k1 : 64), lane, 0, 0, rpb);
                    if (k1 > 64) { const size_t cb = ((size_t)(l * 4 + b) * 4 + h) * 16;
                        attn_range<6, 0, 2>(m, lsum, o, qf, CKM + cb * 3072, CVM + cb * 2048, (k0 > 64 ? k0 : 64) - 64, k1 - 64, lane, 0, 0, rpb); }
                    const int buf = mla_seq & 1;
                    LAS float* mym = xm + (buf * 4 + wave) * 256 + lane;
                    mym[0] = m[0]; mym[64] = m[1]; mym[128] = lsum[0] + __shfl_xor(lsum[0], 32); mym[192] = lsum[1] + __shfl_xor(lsum[1], 32);
                    f32x16 mine = o[0][0];
#pragma unroll
                    for (int s = 0; s < 4; ++s) {
                        if (s == wave) { mine = o[s >> 1][s & 1]; }
                        else { LAS float* dst = xo + (size_t)(((buf * 4 + wave) * 3 + (s - (s > wave ? 1 : 0))) * 1024) + lane;
#pragma unroll
                            for (int r = 0; r < 16; ++r) dst[r * 64] = o[s >> 1][s & 1][r]; }
                    }
                    asm volatile("s_waitcnt lgkmcnt(0)" ::: "memory");
                    __builtin_amdgcn_fence(__ATOMIC_RELEASE, "workgroup");
                    if (lane == 0) __hip_atomic_fetch_add((LAS unsigned*)cnt, 1u, __ATOMIC_RELAXED, __HIP_MEMORY_SCOPE_WORKGROUP);
                    { const unsigned target = 4u * (unsigned)(mla_seq + 1); while (*cnt < target) __builtin_amdgcn_s_sleep(1); }
                    __builtin_amdgcn_fence(__ATOMIC_ACQUIRE, "workgroup");
                    asm volatile("" ::: "memory");
                    const int jq = wave >> 1, dvt = wave & 1;
                    float mw[4], lw[4]; float M = NEGBIG;
#pragma unroll
                    for (int w = 0; w < 4; ++w) { const LAS float* pm = xm + (buf * 4 + w) * 256 + lane; mw[w] = pm[jq * 64]; lw[w] = pm[128 + jq * 64]; M = fmaxf(M, mw[w]); }
                    float L = 0.f; f32x16 acc = {0.f, 0.f, 0.f, 0.f, 0.f, 0.f, 0.f, 0.f, 0.f, 0.f, 0.f, 0.f, 0.f, 0.f, 0.f, 0.f};
#pragma unroll
                    for (int w = 0; w < 4; ++w) { const float aw = __builtin_amdgcn_exp2f(mw[w] - M); L += aw * lw[w];
                        if (w == wave) {
#pragma unroll
                            for (int r = 0; r < 16; ++r) acc[r] += aw * mine[r];
                        } else { const LAS float* ps = xo + (size_t)(((buf * 4 + w) * 3 + (wave - (wave > w ? 1 : 0))) * 1024) + lane;
#pragma unroll
                            for (int r = 0; r < 16; ++r) acc[r] += aw * ps[r * 64]; } }
                    const float inv = 1.0f / L; const int hh = lane >> 5;
                    bf16* mrow = MIX + (size_t)((gtq + jq) * 32 + (lane & 31)) * 1024 + 512 + h * 64 + 32 * dvt + 4 * hh;
                    typedef unsigned u32x2v __attribute__((ext_vector_type(2)));
#pragma unroll
                    for (int g = 0; g < 4; ++g) { u32x2v w0; w0.x = cvtpk(acc[4 * g] * inv, acc[4 * g + 1] * inv); w0.y = cvtpk(acc[4 * g + 2] * inv, acc[4 * g + 3] * inv); *(u32x2v*)(mrow + 8 * g) = w0; }
                }
                for (int it = vb * 4 + wave; it < 1536; it += G * 4) {
                    int lane = tid & 63; asm volatile("" : "+v"(lane));
                    const int gt = it >> 2, g = it & 3;
                    pool_task(PB, WPOOL + (size_t)(l * 4 + g) * 4096, pool_scale + l * 256 + g * 64, MIX, gt, g, lane);
                }
            }
            {
                for (int w0_ = (wave >= 4) ? vb * 4 + (wave - 4) : 1024; w0_ < 1024; w0_ += G * 4)
                for (int it = w0_; it < 1792; it = (it < 512) ? 1792 : (it < 1024 ? 1024 + (it - 512) : it + 512)) {
                    int lane = tid & 63; asm volatile("" : "+v"(lane));
                    if (it < 512) {
                        const int b = it >> 7, h = (it >> 5) & 3, qr = it & 31; const int gt0 = GT_LAT0 + b * 64, gtq = gt0 + qr * 2;
                        bf16x8 qf[2][4]; make_q64(qf, PB, gtq, C_NAQ + h * 64, na_q_norm + l * 64, 0.125f * LOG2E, nullptr, lane);
                        ATTN_INIT(2)
                        int kr0 = qr - 4; kr0 = kr0 < 0 ? 0 : (kr0 > 24 ? 24 : kr0);
                        attn_range<4, 1, 2>(m, lsum, o, qf, KNA + (size_t)h * NGT * 2048, VNA + (size_t)h * NGT * 2048, gt0 + kr0 * 2, gt0 + kr0 * 2 + 16, lane, gt0, qr * 64 + (lane & 31), rpb + 64 + h * 465);
                        const size_t cb = ((size_t)(l * 4 + b) * 4 + h) * 16;
                        attn_range<4, 0, 2>(m, lsum, o, qf, CKNA + cb * 2048, CVNA + cb * 2048, 0, 16, lane, 0, 0, rpb);
#pragma unroll
                        for (int j = 0; j < 2; ++j) attn_store(m[j], lsum[j], o[j][0], o[j][1], false, 0.f, MIX + (size_t)((gtq + j) * 32 + (lane & 31)) * 1024 + 0 + h * 64, lane);
                    } else if (it < 1024) {
                        const int i2 = it - 512; const int b = i2 >> 7, h = (i2 >> 5) & 3, qb = i2 & 31; const int gt0 = GT_LAT0 + b * 64, gtq = gt0 + 2 * qb; const int kvh = h >> 1;
                        bf16x8 qf[2][4]; make_q64(qf, PB, gtq, C_SQ + h * 64, swa_q_norm + l * 64, 0.125f * LOG2E, ROPES, lane);
                        ATTN_INIT(2)
                        const int ta = 2 * qb - 4 < 0 ? 0 : 2 * qb - 4, tb = 2 * qb + 6 > 64 ? 64 : 2 * qb + 6;
                        attn_range<4, 2, 2>(m, lsum, o, qf, KS + (size_t)kvh * NGT * 2048, VS + (size_t)kvh * NGT * 2048, gt0 + ta, gt0 + tb, lane, gt0, qb * 64 + (lane & 31), rpb);
                        const size_t cb = ((size_t)(l * 4 + b) * 2 + kvh) * 16;
                        attn_range<4, 0, 2>(m, lsum, o, qf, CKS + cb * 2048, CVS + cb * 2048, 0, 16, lane, 0, 0, rpb);
                        const float sk = swa_sink[l * 4 + h];
#pragma unroll
                        for (int j = 0; j < 2; ++j) attn_store(m[j], lsum[j], o[j][0], o[j][1], true, sk, MIX + (size_t)((gtq + j) * 32 + (lane & 31)) * 1024 + 768 + h * 64, lane);
                    } else if (it < 1792) {
                        const int j3 = it - 1024; const int kind = j3 >> 8, b = (j3 >> 4) & 15, h = (j3 >> 2) & 3, qb = j3 & 3; const int gt0 = b * 8, gtq = gt0 + 2 * qb;
                        ATTN_INIT(2)
                        if (kind == 1) {
                            bf16x8 qf[2][6]; load_q<6, 2>(qf, QM + (size_t)h * NGT * 3072, gtq, lane);
                            attn_range<6, 0, 2>(m, lsum, o, qf, KM + (size_t)h * NGT * 3072, VM + (size_t)h * NGT * 2048, gt0, gt0 + 8, lane, 0, 0, rpb);
#pragma unroll
                            for (int j = 0; j < 2; ++j) attn_store(m[j], lsum[j], o[j][0], o[j][1], false, 0.f, MIX + (size_t)((gtq + j) * 32 + (lane & 31)) * 1024 + 512 + h * 64, lane);
                        } else if (kind == 0) {
                            bf16x8 qf[2][4]; make_q64(qf, PB, gtq, C_NAQ + h * 64, na_q_norm + l * 64, 0.125f * LOG2E, nullptr, lane);
                            attn_range<4, 0, 2>(m, lsum, o, qf, KNA + (size_t)h * NGT * 2048, VNA + (size_t)h * NGT * 2048, gt0, gt0 + 8, lane, 0, 0, rpb);
#pragma unroll
                            for (int j = 0; j < 2; ++j) attn_store(m[j], lsum[j], o[j][0], o[j][1], false, 0.f, MIX + (size_t)((gtq + j) * 32 + (lane & 31)) * 1024 + 0 + h * 64, lane);
                        } else {
                            const int kvh = h >> 1;
                            bf16x8 qf[2][4]; make_q64(qf, PB, gtq, C_SQ + h * 64, swa_q_norm + l * 64, 0.125f * LOG2E, nullptr, lane);
                            attn_range<4, 0, 2>(m, lsum, o, qf, KS + (size_t)kvh * NGT * 2048, VS + (size_t)kvh * NGT * 2048, gt0, gt0 + 8, lane, 0, 0, rpb);
                            const float sk = swa_sink[l * 4 + h];
#pragma unroll
                            for (int j = 0; j < 2; ++j) attn_store(m[j], lsum[j], o[j][0], o[j][1], true, sk, MIX + (size_t)((gtq + j) * 32 + (lane & 31)) * 1024 + 768 + h * 64, lane);
                        }
                    }
                }
            }
        }
        GRID_BAR();
        }
        {
            PHASE_PTRS
            pg8::Gemm g{MIX, WOUT + (size_t)l * 1024 * 1024, MT, DM, DM}; pg8::StaticOrder S; S.init(MT, DM, G, bid, 192);
            pg8::EpiResid E{l == 0 ? x_prompt : XB, l == 0 ? x_sample : XB + (size_t)M_CTX * 1024, XB, XS, MOD + (size_t)l * 5 * 6144 + 2048, norm2 + l * 1024, MOD + (size_t)l * 5 * 6144 + 4096, PARTD};
            pg8::gemm_phase<pg8::EpiResid, pg8::StaticOrder, true, true, 3>(lds, g, S, E, tid);
        }
        GRID_BAR();
        for (int rep_ = 0; rep_ < REP_D; ++rep_) {
        {
            PHASE_PTRS
            pg8::Gemm g{XS, W1B + (size_t)l * 4096 * 1024, MT, DFF, DM}; pg8::StaticOrder S; S.init(MT, DFF, G, bid);
            pg8::EpiScaleBias<1> E{ZB, DFF, BD + (size_t)l * 5 * 4096, 4096, PARTD};
            pg8::gemm_phase<pg8::EpiScaleBias<1>, pg8::StaticOrder, true, true>(lds, g, S, E, tid);
        }
        GRID_BAR();
        }
        {
            PHASE_PTRS
            const bool last = (l == NL - 1);
            pg8::Gemm g{ZB, W2B + (size_t)l * 1024 * 4096, MT, DM, DFF}; pg8::StaticOrder S; S.init(MT, DM, G, bid, 192);
            pg8::EpiResid E{XB, XB + (size_t)M_CTX * 1024, last ? out : XB, last ? nullptr : XS, MOD + (size_t)l * 5 * 6144 + 5120, norm1 + (last ? 0 : (l + 1) * 1024), MOD + (size_t)(last ? 0 : (l + 1)) * 5 * 6144 + 1024, PARTA};
            pg8::gemm_phase<pg8::EpiResid, pg8::StaticOrder, true, true, 3>(lds, g, S, E, tid);
        }
        if (l + 1 < NL) GRID_BAR();
    }
}
}

extern "C" void kernel_launch(void* const* d_in, const int* in_sizes, int n_in, void* d_out, int out_size, void* d_ws, size_t ws_size, hipStream_t stream) {
    static int grid = 0;
    if (grid == 0) {
        if (n_in != 32 || ws_size < mk::WS_END) { fprintf(stderr, "kernel_launch: unexpected n_in %d / ws_size %zu\n", n_in, ws_size); grid = -1; return; }
        int dev = 0, cus = 0, per_cu = 0;
        hipGetDevice(&dev); hipDeviceGetAttribute(&cus, hipDeviceAttributeMultiprocessorCount, dev);
        if (hipFuncSetAttribute((const void*)mk::fwd_megakernel, hipFuncAttributeMaxDynamicSharedMemorySize, mk::LDS_BYTES) != hipSuccess) { fprintf(stderr, "kernel_launch: hipFuncSetAttribute failed\n"); grid = -1; return; }
        if (hipOccupancyMaxActiveBlocksPerMultiprocessor(&per_cu, (const void*)mk::fwd_megakernel, mk::NTHR, mk::LDS_BYTES) != hipSuccess || per_cu < 1) { fprintf(stderr, "kernel_launch: occupancy query failed (%d)\n", per_cu); (void)hipGetLastError(); per_cu = 1; }
        grid = cus * per_cu;
        fprintf(stderr, "kernel_launch: grid %d (cus %d x %d)\n", grid, cus, per_cu);
    }
    if (grid < 0) return;
    (void)hipMemsetAsync((char*)d_ws + mk::WS_CTL, 0, mk::CTL_ZERO_BYTES, stream);
    mk::Args a{};
    for (int i = 0; i < 32; ++i) a.in[i] = (const float*)d_in[i];
    a.out = (float*)d_out; a.ws = (unsigned char*)d_ws;
    void* params[] = {&a};
    hipError_t e = hipLaunchCooperativeKernel((const void*)mk::fwd_megakernel, dim3(grid), dim3(mk::NTHR), params, mk::LDS_BYTES, stream);
    if (e != hipSuccess) fprintf(stderr, "kernel_launch: cooperative launch failed: %s (grid %d)\n", hipGetErrorString(e), grid);
}
```
